# Optimizing an MI355X kernel written in HIP

```python
import math
import jax, jax.numpy as jnp
from jax import lax
import numpy as np

D_MODEL = 1024
BATCH = 4
SEQ = 4096
DEPTH = 2

N_A_LAYERS = DEPTH // 2
N_B_LAYERS = DEPTH - N_A_LAYERS
HEAD_DIM = 64
N_HEADS = D_MODEL // (2 * HEAD_DIM)
D_FF = 2816
CONV_WIDTH = 3
Q_BLOCK = 128
NORM_EPS = 1e-6

kernel_name = "yoco_shortconv_diffattn_macaron"


def rmsnorm(x, g):
    xf = x.astype(jnp.float32)
    y = xf * lax.rsqrt(jnp.mean(xf * xf, axis=-1, keepdims=True) + NORM_EPS)
    return (y * g.astype(jnp.float32)).astype(x.dtype)


def swiglu(x, w_gu, w_down):
    gate, up = jnp.split(x @ w_gu, 2, axis=-1)
    return (jax.nn.silu(gate) * up) @ w_down


def short_gated_conv(xn, w_in, conv_k, w_out):
    b_gate, c_gate, z = jnp.split(xn @ w_in, 3, axis=-1)
    u = c_gate * z
    rhs = conv_k[:, None, :].astype(u.dtype)
    conv = lax.conv_general_dilated(
        u, rhs, window_strides=(1,), padding=[(CONV_WIDTH - 1, 0)],
        dimension_numbers=('NWC', 'WIO', 'NWC'), feature_group_count=u.shape[-1])
    return (b_gate * conv) @ w_out


def alibi_slopes(n_heads):
    return 2.0 ** (-8.0 * jnp.arange(1, n_heads + 1, dtype=jnp.float32) / n_heads)


def shared_kv(h, kv_norm_g, w_kv):
    Bsz, S, _ = h.shape
    k_flat, v_flat = jnp.split(rmsnorm(h, kv_norm_g) @ w_kv, 2, axis=-1)
    k = k_flat.reshape(Bsz, S, N_HEADS, 2, HEAD_DIM)
    v = v_flat.reshape(Bsz, S, N_HEADS, 2 * HEAD_DIM)
    return k, v


def diff_attention(xn, k, v, w_q, lam_params, subln_g, w_o, lambda_init):
    Bsz, S, _ = xn.shape
    q = (xn @ w_q).reshape(Bsz, S, N_HEADS, 2, HEAD_DIM)
    lp = lam_params.astype(jnp.float32)
    lam = jnp.exp(jnp.sum(lp[0] * lp[1])) - jnp.exp(jnp.sum(lp[2] * lp[3])) + lambda_init
    scale = HEAD_DIM ** -0.5
    n_blocks = S // Q_BLOCK
    q_blocks = q.reshape(Bsz, n_blocks, Q_BLOCK, N_HEADS, 2, HEAD_DIM).swapaxes(0, 1)
    slopes = alibi_slopes(N_HEADS)
    kpos = jnp.arange(S)

    def one_block(args):
        q_blk, start = args
        qpos = start + jnp.arange(Q_BLOCK)
        dist = (qpos[:, None] - kpos[None, :]).astype(jnp.float32)
        s = jnp.einsum('bqhcd,bkhcd->bhcqk', q_blk, k,
                       preferred_element_type=jnp.float32) * scale
        s = s - slopes[None, :, None, None, None] * dist
        s = jnp.where(dist >= 0, s, -jnp.inf)
        p = jax.nn.softmax(s, axis=-1)
        a = p[:, :, 0] - lam * p[:, :, 1]
        return jnp.einsum('bhqk,bkhe->bqhe', a, v)

    o = lax.map(one_block, (q_blocks, jnp.arange(n_blocks) * Q_BLOCK))
    o = o.swapaxes(0, 1).reshape(Bsz, S, N_HEADS, 2 * HEAD_DIM).astype(jnp.float32)
    o = o * lax.rsqrt(jnp.mean(o * o, axis=-1, keepdims=True) + NORM_EPS)
    o = o * subln_g.astype(jnp.float32) * (1.0 - lambda_init)
    return o.reshape(Bsz, S, N_HEADS * 2 * HEAD_DIM).astype(xn.dtype) @ w_o


def setup_inputs(seed: int = 0) -> dict:
    key = jax.random.key(seed)
    ks = jax.random.split(key, 16)
    D = D_MODEL
    nrm = lambda k, shape, fan_in: jax.random.normal(k, shape, jnp.float32) * fan_in ** -0.5
    x = jax.random.normal(ks[0], (BATCH, SEQ, D), jnp.float32)
    ffn_w_gu = nrm(ks[1], (DEPTH, 2, D, 2 * D_FF), D)
    ffn_w_down = nrm(ks[2], (DEPTH, 2, D_FF, D), D_FF)
    norm_g = 1.0 + 0.05 * jax.random.normal(ks[3], (DEPTH, 6, D), jnp.float32)
    conv_w_in = nrm(ks[4], (N_A_LAYERS, D, 3 * D), D)
    conv_k = nrm(ks[5], (N_A_LAYERS, CONV_WIDTH, D), CONV_WIDTH)
    conv_w_out = nrm(ks[6], (N_A_LAYERS, D, D), D)
    kv_norm_g = 1.0 + 0.05 * jax.random.normal(ks[7], (D,), jnp.float32)
    w_kv = nrm(ks[8], (D, 2 * D), D)
    attn_w_q = nrm(ks[9], (N_B_LAYERS, D, D), D)
    attn_lambda = 0.1 * jax.random.normal(ks[10], (N_B_LAYERS, 4, HEAD_DIM), jnp.float32)
    attn_subln_g = 1.0 + 0.05 * jax.random.normal(ks[11], (N_B_LAYERS, 2 * HEAD_DIM), jnp.float32)
    attn_w_o = nrm(ks[12], (N_B_LAYERS, D, D), D)
    return {"x": x, "ffn_w_gu": ffn_w_gu, "ffn_w_down": ffn_w_down, "norm_g": norm_g,
            "conv_w_in": conv_w_in, "conv_k": conv_k, "conv_w_out": conv_w_out,
            "kv_norm_g": kv_norm_g, "w_kv": w_kv, "attn_w_q": attn_w_q,
            "attn_lambda": attn_lambda, "attn_subln_g": attn_subln_g, "attn_w_o": attn_w_o}


def reference(x, ffn_w_gu, ffn_w_down, norm_g, conv_w_in, conv_k, conv_w_out,
              kv_norm_g, w_kv, attn_w_q, attn_lambda, attn_subln_g, attn_w_o):
    h = x
    k = v = None
    for l in range(DEPTH):
        g = norm_g[l]
        if l == N_A_LAYERS:
            k, v = shared_kv(h, kv_norm_g, w_kv)
        h = h + 0.5 * rmsnorm(swiglu(rmsnorm(h, g[0]), ffn_w_gu[l, 0], ffn_w_down[l, 0]), g[1])
        xn = rmsnorm(h, g[2])
        if l < N_A_LAYERS:
            mix = short_gated_conv(xn, conv_w_in[l], conv_k[l], conv_w_out[l])
        else:
            j = l - N_A_LAYERS
            lambda_init = 0.8 - 0.6 * math.exp(-0.3 * l)
            mix = diff_attention(xn, k, v, attn_w_q[j], attn_lambda[j],
                                 attn_subln_g[j], attn_w_o[j], lambda_init)
        h = h + rmsnorm(mix, g[3])
        h = h + 0.5 * rmsnorm(swiglu(rmsnorm(h, g[4]), ffn_w_gu[l, 1], ffn_w_down[l, 1]), g[5])
    return h
```

```cpp
#include <hip/hip_runtime.h>
#include <hip/hip_cooperative_groups.h>
#include <cstdio>
#include <cstdint>
#include <cmath>
namespace cg = cooperative_groups;
namespace pg8 {
#define PG8_LAS __attribute__((address_space(3)))
typedef unsigned short bf16_t;
typedef short bf16x8 __attribute__((ext_vector_type(8)));
typedef float f32x4 __attribute__((ext_vector_type(4)));
typedef unsigned u32x4 __attribute__((ext_vector_type(4)));
constexpr int BM = 256, BK = 64, HALF = 128, HTB = HALF * BK * 2  , STAGE_BYTES = 8 * HTB, NXCD = 8, WGM = 4;

__host__ __device__ __forceinline__ int lds_byte(int r, int c) { const int st = (r >> 4) * 2 + (c >> 5), rr = r & 15, cc = c & 31, ob = rr * 64 + cc * 2; return st * 1024 + (ob ^ (((ob >> 9) & 1) << 5)); }
__host__ __device__ __forceinline__ void stage_rc(int b, int& R, int& C) { const int st = b / 1024, sb = b % 1024, swz = sb ^ (((sb >> 9) & 1) << 5); R = (st >> 1) * 16 + swz / 64; C = (st & 1) * 32 + (swz % 64) / 2; }
__host__ __device__ __forceinline__ int perm32(int rho) { const int n = rho >> 4, i = rho & 15; return 8 * (i >> 2) + 4 * n + (i & 3); }

struct Unit { int pm, pn; };
struct Gemm { const bf16_t* A; const bf16_t* Bt; int M, N, K; };

struct StaticOrder {
    int nM, nN, nwg, G, c;
    __host__ __device__ void init(int M, int N, int G_, int c_) { nM = M / BM; nN = N / BM; nwg = nM * nN; G = G_; c = c_; }
    __host__ __device__ bool next(int i, Unit& u) const {
        const long L = (long)i * G + c; if (L >= nwg) return false;
        int wgid = (int)L; { const int q = nwg / NXCD, r = nwg % NXCD, xcd = wgid % NXCD, off = wgid / NXCD; wgid = (xcd < r ? xcd * (q + 1) : r * (q + 1) + (xcd - r) * q) + off; }
        const int nig = WGM * nN, gid = wgid / nig, fm = gid * WGM, gsz = (nM - fm) < WGM ? (nM - fm) : WGM;
        u.pm = fm + ((wgid % nig) % gsz); u.pn = (wgid % nig) / gsz; return true;
    }
    __device__ __forceinline__ void a_ready(const Unit&) const {}
    __device__ __forceinline__ void done(const Unit&) const {}
};

typedef float f32x2c_t __attribute__((ext_vector_type(2))); typedef __bf16 bf16x2c_t __attribute__((ext_vector_type(2)));
__device__ __forceinline__ unsigned cvt_pk_bf16(float lo, float hi) { f32x2c_t v = {lo, hi}; bf16x2c_t b = __builtin_convertvector(v, bf16x2c_t); return __builtin_bit_cast(unsigned, b); }
typedef float f32x2 __attribute__((ext_vector_type(2)));
__device__ __forceinline__ float silu_f(float v) { return v * __builtin_amdgcn_rcpf(1.0f + __builtin_amdgcn_exp2f(-1.4426950408889634f * v)); }
struct Epi {
    static constexpr bool PERM = true, AFTER_DRAIN = false;
    int mode; bf16_t* O; int ldc; bf16_t* O2; float* part;
    __device__ __forceinline__ void st8(bf16_t* p, const f32x4 v0, const f32x4 v1) const {
        u32x4 w; w.x = cvt_pk_bf16(v0[0], v0[1]); w.y = cvt_pk_bf16(v0[2], v0[3]); w.z = cvt_pk_bf16(v1[0], v1[1]); w.w = cvt_pk_bf16(v1[2], v1[3]);
        *(u32x4*)p = w;
    }
    __device__ __forceinline__ void operator()(const f32x4 (&acc)[2][2][4][2], const Unit& u, int wr, int wc, int fr, int fq) const {
        const int row0 = u.pm * BM + wr * 64 + fr;
        if (mode == 1 || (mode == 2 && u.pn < 8)) {
            const int col0 = u.pn * HALF + wc * 32 + 8 * fq;
#pragma unroll
            for (int ai = 0; ai < 2; ++ai)
#pragma unroll
                for (int m = 0; m < 4; ++m) {
                    bf16_t* rowp = O + (size_t)(row0 + ai * HALF + m * 16) * ldc + col0;
                    f32x4 a0 = acc[ai][0][m][0], a1 = acc[ai][0][m][1]; const f32x4 b0 = acc[ai][1][m][0], b1 = acc[ai][1][m][1];
                    if (mode == 1) {
#pragma unroll
                        for (int e = 0; e < 4; ++e) { a0[e] = silu_f(a0[e]); a1[e] = silu_f(a1[e]); }
                    }
                    st8(rowp, a0 * b0, a1 * b1);
                }
        } else {
            bf16_t* base = O; int colt = u.pn * BM;
            if (mode == 2) { base = O2; colt -= 8 * BM; }
            const int col0 = colt + wc * 32 + 8 * fq;
#pragma unroll
            for (int ai = 0; ai < 2; ++ai)
#pragma unroll
                for (int m = 0; m < 4; ++m) {
                    bf16_t* rowp = base + (size_t)(row0 + ai * HALF + m * 16) * ldc + col0;
#pragma unroll
                    for (int bj = 0; bj < 2; ++bj) st8(rowp + bj * HALF, acc[ai][bj][m][0], acc[ai][bj][m][1]);
                    if (mode == 3) {
                        float s = 0.f;
#pragma unroll
                        for (int bj = 0; bj < 2; ++bj)
#pragma unroll
                            for (int n = 0; n < 2; ++n) { const f32x4 x = acc[ai][bj][m][n]; s += (x[0] * x[0] + x[1] * x[1]) + (x[2] * x[2] + x[3] * x[3]); }
                        s += __shfl_xor(s, 16); s += __shfl_xor(s, 32);
                        if (fq == 0) part[(size_t)(row0 + ai * HALF + m * 16) * 16 + u.pn * 4 + wc] = s;
                    }
                }
        }
    }
};

template <class Epi, class Sched, bool ALIGN_EPI = false, bool SP2 = false>
__device__ __forceinline__ void gemm_phase(PG8_LAS unsigned char* lds, const Gemm g, const Sched& S, const Epi& E) {
    int tid_ = threadIdx.x; asm volatile("" : "+v"(tid_));
    const int tid = tid_, wid = __builtin_amdgcn_readfirstlane(tid >> 6), lane = tid & 63, wr = wid >> 2, wc = wid & 3, fr = lane & 15, fq = lane >> 4;
    const int K = g.K, nt = K / BK;
    unsigned voffA[2], voffB[2];
#pragma unroll
    for (int i = 0; i < 2; ++i) { int R, C; stage_rc(tid * 16 + i * 8192, R, C); const int Rb = Epi::PERM ? ((R & ~31) + perm32(R & 31)) : R;
        voffA[i] = (unsigned)(R * K + C) * 2u; voffB[i] = (unsigned)(Rb * K + C) * 2u; }
    const size_t kstep = (size_t)(BK * 2);
    const size_t hstep = (size_t)HALF * K * 2;
    const size_t tstep = 2 * hstep;
    const unsigned ldsw = (unsigned)wid * 1024u;
    const int aoff = lds_byte(wr * 64 + fr, fq * 8), boff = lds_byte(wc * 32 + fr, fq * 8);
#define PG8_SA(b, h) (((b) * 2 + (h)) * HTB)
#define PG8_SB(b, h) ((4 + (b) * 2 + (h)) * HTB)
#define PG8_STAGE(bufoff, gbase, voff) do { _Pragma("unroll") for (int _i = 0; _i < 2; ++_i) \
        __builtin_amdgcn_global_load_lds((const unsigned*)((const char*)(gbase) + (voff)[_i]), (PG8_LAS unsigned*)(lds + (bufoff) + ldsw + _i * 8192), 16, 0, 0); } while (0)
#define PG8_LDA(dst, b, h) do { _Pragma("unroll") for (int m = 0; m < 4; ++m) _Pragma("unroll") for (int k = 0; k < 2; ++k) dst[m][k] = *(const PG8_LAS bf16x8*)(lds + PG8_SA(b, h) + aoff + m * 2048 + k * 1024); } while (0)
#define PG8_LDB(dst, b, h) do { _Pragma("unroll") for (int n = 0; n < 2; ++n) _Pragma("unroll") for (int k = 0; k < 2; ++k) dst[n][k] = *(const PG8_LAS bf16x8*)(lds + PG8_SB(b, h) + boff + n * 2048 + k * 1024); } while (0)
#define PG8_MMA(ai, bj, At, Bt) do { __builtin_amdgcn_s_setprio(1); _Pragma("unroll") for (int m = 0; m < 4; ++m) _Pragma("unroll") for (int n = 0; n < 2; ++n) _Pragma("unroll") for (int k = 0; k < 2; ++k) \
        acc[ai][bj][m][n] = __builtin_amdgcn_mfma_f32_16x16x32_bf16(Bt[n][k], At[m][k], acc[ai][bj][m][n], 0, 0, 0); __builtin_amdgcn_s_setprio(0); } while (0)
#define PG8_WAIT_V(n) asm volatile("s_waitcnt vmcnt(" #n ")" ::: "memory")
#define PG8_WAIT_L(n) asm volatile("s_waitcnt lgkmcnt(" #n ")" ::: "memory")
#define PG8_BAR __builtin_amdgcn_s_barrier()
#define PG8_SCHED __builtin_amdgcn_sched_barrier(0)
    Unit cur, nxt; int ui = 0;
    if (!S.next(0, cur)) return;
    f32x4 acc[2][2][4][2];
#pragma unroll
    for (int a = 0; a < 2; ++a)
#pragma unroll
        for (int b = 0; b < 2; ++b)
#pragma unroll
            for (int m = 0; m < 4; ++m)
#pragma unroll
                for (int n = 0; n < 2; ++n) acc[a][b][m][n] = (f32x4){0.f, 0.f, 0.f, 0.f};
    bf16x8 At[4][2], B0[2][2], B1[2][2];
    const char* cA = (const char*)g.A + (size_t)cur.pm * tstep; const char* cB = (const char*)g.Bt + (size_t)cur.pn * tstep;
    S.a_ready(cur);
    if constexpr (SP2) {
        PG8_STAGE(PG8_SB(0, 0), cB, voffB); PG8_STAGE(PG8_SB(0, 1), cB + hstep, voffB); PG8_STAGE(PG8_SA(0, 0), cA, voffA); PG8_STAGE(PG8_SA(0, 1), cA + hstep, voffA);
        if (wr == 1) PG8_BAR;
        PG8_WAIT_V(2); PG8_BAR;
        PG8_STAGE(PG8_SB(1, 0), cB + kstep, voffB); PG8_STAGE(PG8_SA(1, 0), cA + kstep, voffA); PG8_STAGE(PG8_SB(1, 1), cB + hstep + kstep, voffB);
        PG8_WAIT_V(6); PG8_BAR;
    } else {
        PG8_STAGE(PG8_SB(0, 0), cB, voffB); PG8_STAGE(PG8_SA(0, 0), cA, voffA); PG8_STAGE(PG8_SB(0, 1), cB + hstep, voffB); PG8_STAGE(PG8_SA(0, 1), cA + hstep, voffA);
        if (wr == 1) PG8_BAR;
        PG8_WAIT_V(4); PG8_BAR;
        PG8_STAGE(PG8_SB(1, 0), cB + kstep, voffB); PG8_STAGE(PG8_SA(1, 0), cA + kstep, voffA); PG8_STAGE(PG8_SB(1, 1), cB + hstep + kstep, voffB);
        PG8_WAIT_V(6); PG8_BAR;
    }
    for (;;) {
        const bool has_next = S.next(ui + 1, nxt);
        const char* nA = has_next ? (const char*)g.A + (size_t)nxt.pm * tstep : cA; const char* nB = has_next ? (const char*)g.Bt + (size_t)nxt.pn * tstep : cB;
        for (int t = 0; t < nt; t += 2) {
            const bool last = (t == nt - 2);
            const char* a1 = cA + (size_t)(t + 1) * kstep;
            const char* a2 = last ? nA : cA + (size_t)(t + 2) * kstep; const char* b2 = last ? nB : cB + (size_t)(t + 2) * kstep;
            const char* a3 = a2 + kstep; const char* b3 = b2 + kstep;
            if (last && has_next) S.a_ready(nxt);
            if constexpr (SP2) {
            PG8_LDB(B0, 0, 0); PG8_LDB(B1, 0, 1); PG8_SCHED; PG8_LDA(At, 0, 0); PG8_STAGE(PG8_SA(1, 1), a1 + hstep, voffA);
            PG8_WAIT_V(8); PG8_WAIT_L(0); PG8_BAR; PG8_MMA(0, 0, At, B0); PG8_MMA(0, 1, At, B1); PG8_BAR; PG8_SCHED;
            PG8_LDA(At, 0, 1); PG8_STAGE(PG8_SB(0, 0), b2, voffB); PG8_STAGE(PG8_SB(0, 1), b2 + hstep, voffB); PG8_STAGE(PG8_SA(0, 0), a2, voffA);
            PG8_WAIT_V(8); PG8_WAIT_L(0); PG8_BAR; PG8_MMA(1, 0, At, B0); PG8_MMA(1, 1, At, B1); PG8_BAR; PG8_SCHED;
            PG8_LDB(B0, 1, 0); PG8_LDB(B1, 1, 1); PG8_SCHED; PG8_LDA(At, 1, 0); PG8_STAGE(PG8_SA(0, 1), a2 + hstep, voffA);
            PG8_WAIT_V(8); PG8_WAIT_L(0); PG8_BAR; PG8_MMA(0, 0, At, B0); PG8_MMA(0, 1, At, B1); PG8_BAR; PG8_SCHED;
            PG8_LDA(At, 1, 1); PG8_STAGE(PG8_SB(1, 0), b3, voffB); PG8_STAGE(PG8_SB(1, 1), b3 + hstep, voffB); PG8_STAGE(PG8_SA(1, 0), a3, voffA);
            PG8_WAIT_V(8); PG8_WAIT_L(0); PG8_BAR; PG8_MMA(1, 0, At, B0); PG8_MMA(1, 1, At, B1); PG8_BAR; PG8_SCHED;
            } else {
            PG8_LDB(B0, 0, 0); PG8_SCHED; PG8_LDA(At, 0, 0); PG8_STAGE(PG8_SA(1, 1), a1 + hstep, voffA);
            PG8_WAIT_L(8); PG8_BAR; PG8_WAIT_L(0); PG8_MMA(0, 0, At, B0); PG8_BAR; PG8_SCHED;
            PG8_LDB(B1, 0, 1); PG8_STAGE(PG8_SB(0, 0), b2, voffB);
            PG8_BAR; PG8_WAIT_L(0); PG8_MMA(0, 1, At, B1); PG8_BAR;
            PG8_LDA(At, 0, 1); PG8_STAGE(PG8_SA(0, 0), a2, voffA);
            PG8_BAR; PG8_WAIT_L(0); PG8_MMA(1, 0, At, B0); PG8_BAR; PG8_SCHED;
            PG8_STAGE(PG8_SB(0, 1), b2 + hstep, voffB);
            PG8_WAIT_V(6); PG8_BAR; PG8_MMA(1, 1, At, B1); PG8_BAR;
            PG8_LDB(B0, 1, 0); PG8_SCHED; PG8_LDA(At, 1, 0); PG8_STAGE(PG8_SA(0, 1), a2 + hstep, voffA);
            PG8_WAIT_L(8); PG8_BAR; PG8_WAIT_L(0); PG8_MMA(0, 0, At, B0); PG8_BAR; PG8_SCHED;
            PG8_LDB(B1, 1, 1); PG8_STAGE(PG8_SB(1, 0), b3, voffB);
            PG8_BAR; PG8_WAIT_L(0); PG8_MMA(0, 1, At, B1); PG8_BAR;
            PG8_LDA(At, 1, 1); PG8_STAGE(PG8_SA(1, 0), a3, voffA);
            PG8_BAR; PG8_WAIT_L(0); PG8_MMA(1, 0, At, B0); PG8_BAR; PG8_SCHED;
            PG8_STAGE(PG8_SB(1, 1), b3 + hstep, voffB);
            PG8_WAIT_V(6); PG8_BAR; PG8_MMA(1, 1, At, B1); PG8_BAR;
            }
        }
        if constexpr (ALIGN_EPI) { if (wr == 0) PG8_BAR; }
        if constexpr (!Epi::AFTER_DRAIN) { E(acc, cur, wr, wc, fr, fq); S.done(cur); }
        if (!has_next) break;
#pragma unroll
        for (int a = 0; a < 2; ++a)
#pragma unroll
            for (int b = 0; b < 2; ++b)
#pragma unroll
                for (int m = 0; m < 4; ++m)
#pragma unroll
                    for (int n = 0; n < 2; ++n) acc[a][b][m][n] = (f32x4){0.f, 0.f, 0.f, 0.f};
        cur = nxt; cA = nA; cB = nB; ++ui;
        if constexpr (ALIGN_EPI) { if (wr == 1) PG8_BAR; }
    }
    PG8_WAIT_V(0);
    if constexpr (!ALIGN_EPI) { if (wr == 0) PG8_BAR; }
    PG8_BAR;
    if constexpr (Epi::AFTER_DRAIN) { E.fused(acc, cur, wr, wc, fr, fq, lds, wid, lane); S.done(cur); }
#undef PG8_SA
#undef PG8_SB
#undef PG8_STAGE
#undef PG8_LDA
#undef PG8_LDB
#undef PG8_MMA
#undef PG8_WAIT_V
#undef PG8_WAIT_L
#undef PG8_BAR
#undef PG8_SCHED
}
}

#define LAS __attribute__((address_space(3)))
typedef unsigned short bf16_t;
typedef short bf16x8 __attribute__((ext_vector_type(8)));
typedef float f32x4 __attribute__((ext_vector_type(4)));
typedef float f32x16 __attribute__((ext_vector_type(16)));
typedef unsigned u32x4 __attribute__((ext_vector_type(4)));
typedef unsigned u32x2 __attribute__((ext_vector_type(2)));
constexpr int D = 1024, SEQ = 4096, NB = 4, M = NB * SEQ, FF = 2816, NH = 8;
constexpr float EPS = 1e-6f;
constexpr float LOG2E = 1.4426950408889634f;
constexpr float LAMBDA_INIT = 0.35550906759096926f;
constexpr int NWAVES = 8, NTHREADS = 512;
constexpr int LDS_BYTES = 135168;

constexpr size_t MiB = 1u << 20;
constexpr size_t WS_PART = 0;
constexpr size_t WS_WGU = 1 * MiB;
constexpr size_t WS_WDN = 45 * MiB;
constexpr size_t WS_WCIN = 67 * MiB, WS_WCOUT = 73 * MiB, WS_WK = 75 * MiB, WS_WV = 77 * MiB, WS_WQ = 79 * MiB, WS_WO = 81 * MiB;
constexpr size_t WS_XN = 83 * MiB;
constexpr size_t WS_F = 115 * MiB;
constexpr size_t WS_K = 147 * MiB;
constexpr size_t WS_VT = 179 * MiB;
constexpr size_t WS_HB = 211 * MiB;
constexpr size_t WS_CTL = 299 * MiB, CTL_BYTES = 65536;
constexpr size_t WS_RINV = 300 * MiB;
constexpr size_t WS_END = 301 * MiB;

__device__ __forceinline__ unsigned f2bf(float f) { unsigned u = __builtin_bit_cast(unsigned, f); return (u + 0x7fffu + ((u >> 16) & 1u)) >> 16; }
__device__ __forceinline__ unsigned pk2(float lo, float hi) { return f2bf(lo) | (f2bf(hi) << 16); }
__device__ __forceinline__ float bflo(unsigned w) { return __builtin_bit_cast(float, w << 16); }
__device__ __forceinline__ float bfhi(unsigned w) { return __builtin_bit_cast(float, w & 0xffff0000u); }
__device__ __forceinline__ float wave_sum(float v) {
#pragma unroll
    for (int o = 1; o < 64; o <<= 1) v += __shfl_xor(v, o);
    return v;
}

__device__ __forceinline__ void transpose_item(const float* W, int K, int Nsrc, bf16_t* WT, int nrows, int mapmode, int off, const float* gk, int gmask, float gscale,
                                               LAS float* scr, int item, int lane) {
    const int nblk = nrows / 32, kb = item / nblk, nb = item % nblk, k0 = 64 * kb, n0 = 32 * nb;
    int c0;
    if (mapmode == 0) c0 = off + n0;
    else if (mapmode == 1) { const int pn = n0 >> 8, j = n0 & 255; c0 = (j >> 7) * FF + pn * 128 + (j & 127); }
    else { if (n0 < 2048) { const int pn = n0 >> 8, j = n0 & 255; c0 = 1024 + (j >> 7) * 1024 + pn * 128 + (j & 127); } else c0 = n0 - 2048; }
    float wv[32];
    const float* wp = W + (size_t)(k0 + (lane >> 5)) * Nsrc + c0 + (lane & 31);
#pragma unroll
    for (int i = 0; i < 32; ++i) wv[i] = wp[(size_t)(2 * i) * Nsrc];
    const int c = lane & 7;
    float gs[8];
#pragma unroll
    for (int e = 0; e < 8; ++e) gs[e] = gk ? gk[(k0 + 8 * c + e) & gmask] * gscale : gscale;
#pragma unroll
    for (int i = 0; i < 32; ++i) scr[(2 * i + (lane >> 5)) * 33 + (lane & 31)] = wv[i];
    asm volatile("s_waitcnt lgkmcnt(0)" ::: "memory");
#pragma unroll
    for (int j = 0; j < 4; ++j) { const int n = (lane >> 3) + 8 * j; const LAS float* s = scr + (8 * c) * 33 + n;
        u32x4 o; o.x = pk2(s[0 * 33] * gs[0], s[1 * 33] * gs[1]); o.y = pk2(s[2 * 33] * gs[2], s[3 * 33] * gs[3]); o.z = pk2(s[4 * 33] * gs[4], s[5 * 33] * gs[5]); o.w = pk2(s[6 * 33] * gs[6], s[7 * 33] * gs[7]);
        *(u32x4*)(WT + (size_t)(n0 + n) * K + k0 + 8 * c) = o; }
    asm volatile("s_waitcnt lgkmcnt(0)" ::: "memory");
}

struct Params { const float* in[13]; float* out; unsigned char* ws; };

__device__ __forceinline__ void convert_weights(const Params& p, LAS unsigned char* lds, int which, int w0, int wstride, int wave, int lane) {
    LAS float* scr = (LAS float*)(lds + wave * 16384);
    constexpr int I_GU = (D / 64) * (2 * FF / 32), I_DN = (FF / 64) * (D / 32), I_CIN = (D / 64) * (3 * D / 32), I_SQ = (D / 64) * (D / 32);
    unsigned char* ws = p.ws;
    const int nitems = (which == 0) ? I_GU + I_DN + I_CIN + I_SQ : (which == 1) ? 3 * I_SQ + I_GU + I_DN : (which == 2) ? I_SQ + I_GU + I_DN : I_GU + I_DN;
#define TGU(j, r) transpose_item(p.in[1] + (size_t)(j) * D * 2 * FF, D, 2 * FF, (bf16_t*)(ws + WS_WGU) + (size_t)(j) * 2 * FF * D, 2 * FF, 1, 0, p.in[3] + (((j) >> 1) * 6 + (((j) & 1) ? 4 : 0)) * D, D - 1, 1.f, scr, r, lane)
#define TDN(j, r) transpose_item(p.in[2] + (size_t)(j) * FF * D, FF, D, (bf16_t*)(ws + WS_WDN) + (size_t)(j) * D * FF, D, 0, 0, nullptr, 0, 1.f, scr, r, lane)
    for (int it = w0; it < nitems; it += wstride) {
        int r = it;
        if (which == 3) { if (r < I_GU) { TGU(1, r); continue; } r -= I_GU; TDN(1, r); continue; }
        if (which == 0) {
            if (r < I_GU) { TGU(0, r); continue; }
            r -= I_GU;
            if (r < I_DN) { TDN(0, r); continue; }
            r -= I_DN;
            if (r < I_CIN) { transpose_item(p.in[4], D, 3 * D, (bf16_t*)(ws + WS_WCIN), 3 * D, 2, 0, p.in[3] + 2 * D, D - 1, 1.f, scr, r, lane); continue; }
            r -= I_CIN;
            transpose_item(p.in[6], D, D, (bf16_t*)(ws + WS_WCOUT), D, 0, 0, nullptr, 0, 1.f, scr, r, lane);
        } else if (which == 1) {
            if (r < I_SQ) { transpose_item(p.in[8], D, 2 * D, (bf16_t*)(ws + WS_WK), D, 0, 0, p.in[7], D - 1, 1.f, scr, r, lane); continue; }
            r -= I_SQ;
            if (r < I_SQ) { transpose_item(p.in[8], D, 2 * D, (bf16_t*)(ws + WS_WV), D, 0, D, p.in[7], D - 1, 1.f, scr, r, lane); continue; }
            r -= I_SQ;
            if (r < I_GU) { TGU(2, r); continue; }
            r -= I_GU;
            if (r < I_DN) { TDN(2, r); continue; }
            r -= I_DN;
            transpose_item(p.in[9], D, D, (bf16_t*)(ws + WS_WQ), D, 0, 0, p.in[3] + (6 + 2) * D, D - 1, 0.125f * LOG2E, scr, r, lane);
        } else {
            if (r < I_SQ) { transpose_item(p.in[12], D, D, (bf16_t*)(ws + WS_WO), D, 0, 0, p.in[11], 127, 1.0f - LAMBDA_INIT, scr, r, lane); continue; }
            r -= I_SQ;
            if (r < I_GU) { TGU(3, r); continue; }
            r -= I_GU;
            TDN(3, r);
        }
    }
#undef TGU
#undef TDN
}

__device__ __forceinline__ void rowpass(const float* base, const bf16_t* Xp, float* rinv, const bf16_t* F, const float* part, const float* g, float coef, float* outF, bf16_t* XN, int r0, int rend, int rstride, int lane) {
    f32x4 gg[4];
#pragma unroll
    for (int j = 0; j < 4; ++j) gg[j] = F ? ((const f32x4*)g)[lane + 64 * j] : (f32x4){0.f, 0.f, 0.f, 0.f};
    f32x4 hb[4]; u32x2 xb[4], fb[4]; float ps = 0.f, ri = 0.f;
#define RP_LOAD(mm, H_, X_, F_, P_, R_) do { \
        if (base) { const f32x4* br_ = (const f32x4*)(base + (size_t)(mm) * D) + lane; _Pragma("unroll") for (int j = 0; j < 4; ++j) H_[j] = br_[64 * j]; } \
        else { const u32x2* xr_ = (const u32x2*)(Xp + (size_t)(mm) * D) + lane; _Pragma("unroll") for (int j = 0; j < 4; ++j) X_[j] = xr_[64 * j]; R_ = rinv[(mm)]; } \
        if (F) { const u32x2* fr_ = (const u32x2*)(F + (size_t)(mm) * D) + lane; _Pragma("unroll") for (int j = 0; j < 4; ++j) F_[j] = fr_[64 * j]; \
                 P_ = (lane < 16) ? part[(size_t)(mm) * 16 + lane] : 0.f; } } while (0)
#pragma unroll
    for (int j = 0; j < 4; ++j) { fb[j] = (u32x2){0u, 0u}; xb[j] = (u32x2){0u, 0u}; hb[j] = (f32x4){0.f, 0.f, 0.f, 0.f}; }
    if (r0 < rend) RP_LOAD(r0, hb, xb, fb, ps, ri);
    for (int m = r0; m < rend; m += rstride) {
        f32x4 hn[4]; u32x2 xn[4], fn[4]; float pn = 0.f, rn = 0.f;
#pragma unroll
        for (int j = 0; j < 4; ++j) { hn[j] = (f32x4){0.f, 0.f, 0.f, 0.f}; fn[j] = (u32x2){0u, 0u}; xn[j] = (u32x2){0u, 0u}; }
        if (m + rstride < rend) RP_LOAD(m + rstride, hn, xn, fn, pn, rn);
        f32x4 v[4]; float s = 0.f;
#pragma unroll
        for (int j = 0; j < 4; ++j) v[j] = base ? hb[j] : (f32x4){bflo(xb[j].x), bfhi(xb[j].x), bflo(xb[j].y), bfhi(xb[j].y)} * ri;
        if (F) {
            const float rF = coef / sqrtf(wave_sum(ps) * (1.0f / D) + EPS);
#pragma unroll
            for (int j = 0; j < 4; ++j) { const u32x2 f = fb[j];
                const f32x4 fv = (f32x4){bflo(f.x), bfhi(f.x), bflo(f.y), bfhi(f.y)};
                v[j] = v[j] + fv * gg[j] * rF; }
        }
        if (outF) { f32x4* orow = (f32x4*)(outF + (size_t)m * D) + lane;
#pragma unroll
            for (int j = 0; j < 4; ++j) orow[64 * j] = v[j]; }
        if (XN) {
#pragma unroll
            for (int j = 0; j < 4; ++j) s += (v[j].x * v[j].x + v[j].y * v[j].y) + (v[j].z * v[j].z + v[j].w * v[j].w);
            const float ms = wave_sum(s) * (1.0f / D) + EPS, rstd = 1.0f / sqrtf(ms);
            u32x2* xo = (u32x2*)(XN + (size_t)m * D) + lane;
#pragma unroll
            for (int j = 0; j < 4; ++j) { u32x2 w; w.x = pk2(v[j].x * rstd, v[j].y * rstd); w.y = pk2(v[j].z * rstd, v[j].w * rstd); xo[64 * j] = w; }
            if (lane == 0) rinv[m] = sqrtf(ms);
        }
#pragma unroll
        for (int j = 0; j < 4; ++j) { hb[j] = hn[j]; fb[j] = fn[j]; xb[j] = xn[j]; }
        ps = pn; ri = rn;
    }
#undef RP_LOAD
}

__device__ __forceinline__ void unpack8(const u32x4 w, float (&f)[8]) { f[0] = bflo(w.x); f[1] = bfhi(w.x); f[2] = bflo(w.y); f[3] = bfhi(w.y); f[4] = bflo(w.z); f[5] = bfhi(w.z); f[6] = bflo(w.w); f[7] = bfhi(w.w); }
__device__ __forceinline__ void convpass(const bf16_t* U, const bf16_t* Bg, const float* ck, bf16_t* Y, int i0, int iend, int istride, int lane) {
    constexpr int RCH = 8, NITEM = (M / RCH) * 2;
    for (int it = i0; it < iend; it += istride) {
        const int rc = it >> 1, hh = it & 1, col = hh * 512 + lane * 8, t0 = rc * RCH;
        u32x4 ur[RCH + 2], br[RCH];
        const bool head = (t0 & (SEQ - 1)) == 0;
        ur[0] = head ? (u32x4){0u, 0u, 0u, 0u} : *(const u32x4*)(U + (size_t)(t0 - 2) * D + col);
        ur[1] = head ? (u32x4){0u, 0u, 0u, 0u} : *(const u32x4*)(U + (size_t)(t0 - 1) * D + col);
#pragma unroll
        for (int i = 0; i < RCH; ++i) { ur[i + 2] = *(const u32x4*)(U + (size_t)(t0 + i) * D + col); br[i] = *(const u32x4*)(Bg + (size_t)(t0 + i) * D + col); }
        float k0[8], k1[8], k2[8], um2[8], um1[8];
#pragma unroll
        for (int e = 0; e < 8; ++e) { k0[e] = ck[col + e]; k1[e] = ck[D + col + e]; k2[e] = ck[2 * D + col + e]; }
        unpack8(ur[0], um2); unpack8(ur[1], um1);
#pragma unroll
        for (int i = 0; i < RCH; ++i) {
            float u[8], b[8], y[8];
            unpack8(ur[i + 2], u); unpack8(br[i], b);
#pragma unroll
            for (int e = 0; e < 8; ++e) { y[e] = b[e] * (k0[e] * um2[e] + k1[e] * um1[e] + k2[e] * u[e]); um2[e] = um1[e]; um1[e] = u[e]; }
            u32x4 w; w.x = pk2(y[0], y[1]); w.y = pk2(y[2], y[3]); w.z = pk2(y[4], y[5]); w.w = pk2(y[6], y[7]);
            *(u32x4*)(Y + (size_t)(t0 + i) * D + col) = w;
        }
    }
}

namespace att {
constexpr int KROW = 72, K_BYTES = 64 * KROW * 2, V_BYTES = 128 * KROW * 2, STAGE = 2 * K_BYTES + V_BYTES;
constexpr int PFD = 1;
constexpr int NSTG = 3;
constexpr int OFF_SCR = NSTG * STAGE;
constexpr int OFF_OST = 65536;
constexpr int OST_ROW = 136;
static_assert(OFF_OST + 4 * 32 * OST_ROW * 2 <= NSTG * STAGE && OFF_SCR + 8 * 256 <= 131072, "attention LDS");
__device__ __forceinline__ float max3f(float a, float b, float c) { float r; asm("v_max3_f32 %0, %1, %2, %3" : "=v"(r) : "v"(a), "v"(b), "v"(c)); return r; }
__device__ __forceinline__ int crow(int r, int hi) { return (r & 3) + 8 * (r >> 2) + 4 * hi; }
__device__ __forceinline__ int swap23(int i) { return (i & ~12) | ((i & 4) << 1) | ((i & 8) >> 1); }
typedef float f32x2_t __attribute__((ext_vector_type(2))); typedef __bf16 bf16x2_t __attribute__((ext_vector_type(2)));
__device__ __forceinline__ unsigned cvtpk(float lo, float hi) { f32x2_t v = {lo, hi}; bf16x2_t b = __builtin_convertvector(v, bf16x2_t); return __builtin_bit_cast(unsigned, b); }

struct AttnPre { bf16x8 qf[4]; u32x4 kr[2], vr[2]; };
__device__ __forceinline__ void attn_prefetch(AttnPre& P, int b, int h, int qb, const bf16_t* Q, const bf16_t* Kb, const bf16_t* Vt) {
    int tid_ = threadIdx.x; asm volatile("" : "+v"(tid_));
    const int tid = tid_, lane = tid & 63, r32 = lane & 31, hi = lane >> 5;
    const int wid = __builtin_amdgcn_readfirstlane(tid >> 6), c = wid >> 2, qs = wid & 3;
    const size_t tok0 = (size_t)b * SEQ;
    const bf16_t* qp = Q + (tok0 + qb * 128 + qs * 32 + r32) * D + h * 128 + c * 64 + hi * 8;
#pragma unroll
    for (int d0 = 0; d0 < 4; ++d0) P.qf[d0] = *(const bf16x8*)(qp + d0 * 16);
#pragma unroll
    for (int i = 0; i < 2; ++i) { const int id = tid + 512 * i;
        { const int row = id >> 4, ch = id & 15; P.kr[i] = *(const u32x4*)(Kb + (tok0 + row) * D + h * 128 + ch * 8); }
        { const int d = id >> 3, ch = id & 7; P.vr[i] = *(const u32x4*)(Vt + (size_t)(h * 128 + d) * M + tok0 + ch * 8); } }
}
__device__ __forceinline__ void attn_unit(int b, int h, int qb, const bf16_t* Q, const bf16_t* Kb, const bf16_t* Vt, bf16_t* O, LAS unsigned char* lds, float lam, float slope2,
                                          const AttnPre& pre, bool hn, int nb, int nh, int nqb, AttnPre& nxt) {
    int tid_ = threadIdx.x; asm volatile("" : "+v"(tid_));
    const int tid = tid_, lane = tid & 63, r32 = lane & 31, hi = lane >> 5;
    const int wid = __builtin_amdgcn_readfirstlane(tid >> 6), c = wid >> 2, qs = wid & 3;
    const int q0w = qb * 128 + qs * 32;
    const size_t tok0 = (size_t)b * SEQ;
    LAS float* scr = (LAS float*)(lds + OFF_SCR) + wid * 64;
    bf16x8 qf[4];
#pragma unroll
    for (int d0 = 0; d0 < 4; ++d0) qf[d0] = pre.qf[d0];
    const bf16_t* kg[2]; const bf16_t* vg[2]; int kl[2], vl[2];
#pragma unroll
    for (int i = 0; i < 2; ++i) { const int id = tid + 512 * i;
        { const int row = id >> 4, ch = id & 15; kg[i] = Kb + (tok0 + row) * D + h * 128 + ch * 8; kl[i] = (ch >> 3) * K_BYTES + (row * KROW + (ch & 7) * 8) * 2; }
        { const int d = id >> 3, ch = id & 7; vg[i] = Vt + (size_t)(h * 128 + d) * M + tok0 + ch * 8; vl[i] = 2 * K_BYTES + (d * KROW + ch * 8) * 2; } }
    const int NT = 2 * qb + 2;
    u32x4 krA[2], vrA[2], krB[2], vrB[2];
#pragma unroll
    for (int i = 0; i < 2; ++i) { krA[i] = pre.kr[i]; vrA[i] = pre.vr[i]; }
    if (PFD == 2) {
#pragma unroll
        for (int i = 0; i < 2; ++i) { krB[i] = *(const u32x4*)(kg[i] + (size_t)64 * D); vrB[i] = *(const u32x4*)(vg[i] + 64); } }
#pragma unroll
    for (int i = 0; i < 2; ++i) { *(LAS u32x4*)(lds + kl[i]) = krA[i]; *(LAS u32x4*)(lds + vl[i]) = vrA[i]; }
    __syncthreads();
    f32x16 o[4];
#pragma unroll
    for (int d0 = 0; d0 < 4; ++d0)
#pragma unroll
        for (int r = 0; r < 16; ++r) o[d0][r] = 0.f;
    float mref = 0.f, l = 0.f;
    const int kofs = (swap23(r32) * KROW + hi * 8) * 2, vofs = (r32 * KROW + hi * 8) * 2;
    const float posref = (float)(qb * 128 + 127);
    u32x4 pw[4]; bool pend = false;
#define LDV(dst, ks) do { _Pragma("unroll") for (int d0 = 0; d0 < 4; ++d0) dst[d0] = *(const LAS bf16x8*)(vb + d0 * 32 * KROW * 2 + (ks) * 32); } while (0)
#define PVM(ks, src) do { _Pragma("unroll") for (int d0 = 0; d0 < 4; ++d0) o[d0] = __builtin_amdgcn_mfma_f32_32x32x16_bf16(__builtin_bit_cast(bf16x8, pw[ks]), src[d0], o[d0], 0, 0, 0); } while (0)
#define PV_ALL(vstage) do { const LAS unsigned char* vb = (vstage) + 2 * K_BYTES + vofs; bf16x8 va[4], vn[4]; \
        LDV(va, 0); LDV(vn, 1); __builtin_amdgcn_sched_barrier(0); PVM(0, va); __builtin_amdgcn_sched_barrier(0); \
        LDV(va, 2); __builtin_amdgcn_sched_barrier(0); PVM(1, vn); __builtin_amdgcn_sched_barrier(0); \
        LDV(vn, 3); __builtin_amdgcn_sched_barrier(0); PVM(2, va); __builtin_amdgcn_sched_barrier(0); PVM(3, vn); __builtin_amdgcn_sched_barrier(0); } while (0)
    int sc = 0, sp = 0;
    auto tile_step = [&](const int t, u32x4 (&KL)[2], u32x4 (&VL)[2], u32x4 (&KW)[2], u32x4 (&VW)[2]) __attribute__((always_inline))     {
        LAS unsigned char* stg = lds + sc;
        if (t + PFD < NT) {
#pragma unroll
            for (int i = 0; i < 2; ++i) { KL[i] = *(const u32x4*)(kg[i] + (size_t)(t + PFD) * 64 * D); VL[i] = *(const u32x4*)(vg[i] + (t + PFD) * 64); }
        }
        const int kvb = 64 * t;
        if (kvb <= q0w + 31) {
            const LAS unsigned char* kb = stg + c * K_BYTES + kofs;
            bf16x8 ka[8];
#pragma unroll
            for (int d0 = 0; d0 < 4; ++d0) { ka[2 * d0] = *(const LAS bf16x8*)(kb + d0 * 32); ka[2 * d0 + 1] = *(const LAS bf16x8*)(kb + 32 * KROW * 2 + d0 * 32); }
            __builtin_amdgcn_sched_barrier(0);
            const float tcl = slope2 * ((float)(kvb + 8 * hi) - posref) - mref;
            f32x16 p0, p1;
#pragma unroll
            for (int r = 0; r < 16; ++r) { const float kvrel = (float)((r & 7) + 16 * (r >> 3)); p0[r] = __builtin_fmaf(slope2, kvrel, tcl); p1[r] = __builtin_fmaf(slope2, kvrel + 32.f, tcl); }
#pragma unroll
            for (int d0 = 0; d0 < 4; ++d0) {
                p0 = __builtin_amdgcn_mfma_f32_32x32x16_bf16(ka[2 * d0], qf[d0], p0, 0, 0, 0);
                p1 = __builtin_amdgcn_mfma_f32_32x32x16_bf16(ka[2 * d0 + 1], qf[d0], p1, 0, 0, 0); }
            asm volatile("s_nop 15\n\ts_nop 7" : "+v"(p0), "+v"(p1));
            __builtin_amdgcn_sched_barrier(0);
            if (kvb + 63 > q0w) {
                const int qabs = q0w + r32;
#pragma unroll
                for (int r = 0; r < 16; ++r) { const int kv = kvb + 8 * hi + (r & 7) + 16 * (r >> 3);
                    if (kv > qabs) p0[r] = -INFINITY; if (kv + 32 > qabs) p1[r] = -INFINITY; }
            }
            float mx = max3f(p0[0], p1[0], p0[1]), mx2 = max3f(p1[1], p0[2], p1[2]);
#pragma unroll
            for (int r = 3; r < 15; r += 2) { mx = max3f(mx, p0[r], p1[r]); mx2 = max3f(mx2, p0[r + 1], p1[r + 1]); }
            mx = max3f(mx, p0[15], p1[15]); mx = fmaxf(mx, mx2);
            mx = fmaxf(mx, __shfl_xor(mx, 32));
            if (t == 0 || __any(mx > 96.0f)) {
                const float dl = (t == 0) ? mx : fmaxf(mx, 0.f);
                mref += dl;
#pragma unroll
                for (int r = 0; r < 16; ++r) { p0[r] -= dl; p1[r] -= dl; }
                if (t != 0) {
                    const float alpha = __builtin_amdgcn_exp2f(-dl);
                    l *= alpha;
                    if (hi == 0) scr[r32] = alpha;
                    asm volatile("s_waitcnt lgkmcnt(0)" ::: "memory");
#pragma unroll
                    for (int r = 0; r < 16; ++r) { const float a = scr[crow(r, hi)];
#pragma unroll
                        for (int d0 = 0; d0 < 4; ++d0) o[d0][r] *= a; }
                }
            }
            const LAS unsigned char* vb = stg + 2 * K_BYTES + vofs;
            bf16x8 va[4], vn[4];
            LDV(va, 0); LDV(vn, 1);
            float sacc = 0.f;
#define EXPQ(k, q) do { float ea_, eb_; if ((k) < 2) { ea_ = __builtin_amdgcn_exp2f(p0[((k) & 1) * 8 + 2 * (q)]); eb_ = __builtin_amdgcn_exp2f(p0[((k) & 1) * 8 + 2 * (q) + 1]); } \
                                        else { ea_ = __builtin_amdgcn_exp2f(p1[((k) & 1) * 8 + 2 * (q)]); eb_ = __builtin_amdgcn_exp2f(p1[((k) & 1) * 8 + 2 * (q) + 1]); } \
                                        sacc += ea_; sacc += eb_; asm volatile("" : "+v"(sacc)); pw[k][q] = cvtpk(ea_, eb_); } while (0)
#define MMAQ(ks, src, d0) o[d0] = __builtin_amdgcn_mfma_f32_32x32x16_bf16(__builtin_bit_cast(bf16x8, pw[ks]), src[d0], o[d0], 0, 0, 0)
#define SB() __builtin_amdgcn_sched_barrier(0)
            EXPQ(0, 0); EXPQ(0, 1); EXPQ(0, 2); EXPQ(0, 3); SB();
            MMAQ(0, va, 0); EXPQ(1, 0); SB(); MMAQ(0, va, 1); EXPQ(1, 1); SB(); MMAQ(0, va, 2); EXPQ(1, 2); SB(); MMAQ(0, va, 3); EXPQ(1, 3); SB();
            LDV(va, 2); SB();
            MMAQ(1, vn, 0); EXPQ(2, 0); SB(); MMAQ(1, vn, 1); EXPQ(2, 1); SB(); MMAQ(1, vn, 2); EXPQ(2, 2); SB(); MMAQ(1, vn, 3); EXPQ(2, 3); SB();
            LDV(vn, 3); SB();
            MMAQ(2, va, 0); EXPQ(3, 0); SB(); MMAQ(2, va, 1); EXPQ(3, 1); SB(); MMAQ(2, va, 2); EXPQ(3, 2); SB(); MMAQ(2, va, 3); EXPQ(3, 3); SB();
            MMAQ(3, vn, 0); MMAQ(3, vn, 1); MMAQ(3, vn, 2); MMAQ(3, vn, 3); SB();
            l += sacc;
#undef EXPQ
#undef MMAQ
#undef SB
        }
        const int sn = (sc == (NSTG - 1) * STAGE) ? 0 : sc + STAGE;
        if (t + 1 < NT) {
            LAS unsigned char* nst = lds + sn;
#pragma unroll
            for (int i = 0; i < 2; ++i) { *(LAS u32x4*)(nst + kl[i]) = KW[i]; *(LAS u32x4*)(nst + vl[i]) = VW[i]; }
        }
        sp = sc; sc = sn;
        __syncthreads();
    };
    if (PFD == 2) { for (int t = 0; t < NT; t += 2) { tile_step(t, krA, vrA, krB, vrB); tile_step(t + 1, krB, vrB, krA, vrA); } }
    else { for (int t = 0; t < NT; ++t) tile_step(t, krA, vrA, krA, vrA); }
    __syncthreads();
    if (hn) attn_prefetch(nxt, nb, nh, nqb, Q, Kb, Vt);
    else {
#pragma unroll
        for (int d0 = 0; d0 < 4; ++d0) nxt.qf[d0] = (bf16x8){0, 0, 0, 0, 0, 0, 0, 0};
#pragma unroll
        for (int i = 0; i < 2; ++i) { nxt.kr[i] = (u32x4){0u, 0u, 0u, 0u}; nxt.vr[i] = (u32x4){0u, 0u, 0u, 0u}; } }
#undef LDV
#undef PVM
#undef PV_ALL
    l += __shfl_xor(l, 32);
    if (hi == 0) scr[r32] = l;
    asm volatile("s_waitcnt lgkmcnt(0)" ::: "memory");
    const float fmap = (c == 1) ? lam : 1.0f;
#pragma unroll
    for (int r = 0; r < 16; ++r) { const float il = fmap / scr[crow(r, hi)];
#pragma unroll
        for (int d0 = 0; d0 < 4; ++d0) o[d0][r] *= il; }
    LAS float* exch = (LAS float*)lds + qs * 4096;
    if (c == 1) {
#pragma unroll
        for (int d0 = 0; d0 < 4; ++d0)
#pragma unroll
            for (int r = 0; r < 16; ++r) exch[(d0 * 16 + r) * 64 + lane] = o[d0][r];
    }
    __syncthreads();
    if (c == 0) {
#pragma unroll
        for (int d0 = 0; d0 < 4; ++d0)
#pragma unroll
            for (int r = 0; r < 16; ++r) o[d0][r] -= exch[(d0 * 16 + r) * 64 + lane];
        LAS bf16_t* ost = (LAS bf16_t*)(lds + OFF_OST) + qs * 32 * OST_ROW;
#pragma unroll
        for (int r = 0; r < 16; ++r) {
            float ss = 0.f;
#pragma unroll
            for (int d0 = 0; d0 < 4; ++d0) ss += o[d0][r] * o[d0][r];
            ss += __shfl_xor(ss, 1); ss += __shfl_xor(ss, 2); ss += __shfl_xor(ss, 4); ss += __shfl_xor(ss, 8); ss += __shfl_xor(ss, 16);
            const float rs = 1.0f / sqrtf(ss * (1.0f / 128.0f) + EPS);
#pragma unroll
            for (int d0 = 0; d0 < 4; ++d0) ost[crow(r, hi) * OST_ROW + d0 * 32 + r32] = (bf16_t)f2bf(o[d0][r] * rs);
        }
        asm volatile("s_waitcnt lgkmcnt(0)" ::: "memory");
        bf16_t* og = O + (tok0 + q0w) * D + h * 128;
#pragma unroll
        for (int i = 0; i < 8; ++i) { const int id = i * 64 + lane, row = id >> 4, ch = id & 15;
            const u32x4 v = *(const LAS u32x4*)(ost + row * OST_ROW + ch * 8);
            *(u32x4*)(og + (size_t)row * D + ch * 8) = v; }
    }
    __syncthreads();
}
}

#define XB_TMO      128
#define XB_XCNT(j)  (256  + 64 * (j))
#define XB_XSUB(j)  (1280 + 64 * (j))
#define XB_XGEN(j)  (2304 + 64 * (j))
#define XB_TOP      3328
#define XB_TOPGEN   3392
#define XCD_BAR_WORDS 3456
#define XB_SPIN_CAP (1u << 18)

__device__ __forceinline__ unsigned xb_ld(unsigned* p)              { return __hip_atomic_load(p, __ATOMIC_RELAXED, __HIP_MEMORY_SCOPE_AGENT); }
__device__ __forceinline__ unsigned xb_add(unsigned* p, unsigned v) { return __hip_atomic_fetch_add(p, v, __ATOMIC_RELAXED, __HIP_MEMORY_SCOPE_AGENT); }
__device__ __forceinline__ unsigned xb_xcc_id() { return (unsigned)__builtin_amdgcn_s_getreg((3 << 11) | 20) & 0xFu; }
#define XB_SPIN(cond, bar) do { unsigned _sp = 0; while (cond) { __builtin_amdgcn_s_sleep(1); \
    if ((++_sp & 255u) == 0u) { if (xb_ld(&(bar)[XB_TMO])) break; if (_sp > XB_SPIN_CAP) { atomicAdd(&(bar)[XB_TMO], 1u); break; } } } } while (0)

struct XcdBarrier {
    unsigned* bar; unsigned x;
    volatile LAS unsigned* st;
};

__device__ __forceinline__ XcdBarrier xcd_barrier_post(unsigned* bar, volatile LAS unsigned* st) {
    XcdBarrier b; b.bar = bar; b.x = xb_xcc_id(); b.st = st;
    if (threadIdx.x == 0) (void)xb_add(&bar[XB_XCNT(b.x)], 1u);
    return b;
}
__device__ __forceinline__ void xcd_barrier_complete(unsigned* bar, unsigned x, unsigned& nloc, unsigned& nx) {
    const unsigned G = gridDim.x * gridDim.y * gridDim.z;
    unsigned sum, cnt, mine, sp = 0u;
    for (;;) {
        sum = 0u; cnt = 0u; mine = 0u;
#pragma unroll
        for (unsigned j = 0; j < 16; ++j) { const unsigned c = xb_ld(&bar[XB_XCNT(j)]); sum += c; cnt += (c > 0u) ? 1u : 0u; mine = (j == x) ? c : mine; }
        if (sum == G) break;
        __builtin_amdgcn_s_sleep(1);
        if ((++sp & 255u) == 0u) { if (xb_ld(&bar[XB_TMO])) break; if (sp > XB_SPIN_CAP) { atomicAdd(&bar[XB_TMO], 1u); break; } }
    }
    nloc = mine > 0u ? mine : 1u; nx = cnt > 0u ? cnt : 1u;
}

__device__ __forceinline__ void xcd_barrier(const XcdBarrier& b) {
    asm volatile("s_waitcnt vmcnt(0)" ::: "memory");
    __syncthreads();
    if (threadIdx.x == 0) {
        unsigned* bar = b.bar;
        __builtin_amdgcn_s_waitcnt(0);
        unsigned nloc = b.st[0], nx = b.st[1];
        if (nloc == 0u) { xcd_barrier_complete(bar, b.x, nloc, nx); b.st[0] = nloc; b.st[1] = nx; }
        const unsigned old = xb_add(&bar[XB_XSUB(b.x)], 1u);
        const unsigned gen = old / nloc;
        if (old + 1u == (gen + 1u) * nloc) {
            __builtin_amdgcn_fence(__ATOMIC_RELEASE, "agent");
            asm volatile("s_waitcnt vmcnt(0)" ::: "memory");
            const unsigned og = xb_add(&bar[XB_TOP], 1u);
            const unsigned tg = og / nx;
            if (og + 1u == (tg + 1u) * nx) xb_add(&bar[XB_TOPGEN], 1u);
            else XB_SPIN(xb_ld(&bar[XB_TOPGEN]) == tg, bar);
            __builtin_amdgcn_fence(__ATOMIC_ACQUIRE, "agent");
            xb_add(&bar[XB_XGEN(b.x)], 1u);
            asm volatile("s_waitcnt vmcnt(0)" ::: "memory");
        } else {
            XB_SPIN(xb_ld(&bar[XB_XGEN(b.x)]) == gen, bar);
            __builtin_amdgcn_fence(__ATOMIC_ACQUIRE, "agent");
            asm volatile("s_waitcnt vmcnt(0)" ::: "memory");
        }
    }
    __syncthreads();
}

#define XL_SUB(j)  (4096 + 64 * (j))
#define XL_GEN(j)  (4096 + 1024 + 64 * (j))
#define XL_RANK(j) (4096 + 2048 + 64 * (j))
__device__ __forceinline__ void xcd_local_barrier(unsigned* ctl, unsigned x) {
    asm volatile("s_waitcnt vmcnt(0)" ::: "memory");
    __syncthreads();
    if (threadIdx.x == 0) {
        const unsigned old = xb_add(&ctl[XL_SUB(x)], 1u), gen = old / 32u;
        if (old + 1u == (gen + 1u) * 32u) xb_add(&ctl[XL_GEN(x)], 1u);
        else XB_SPIN(xb_ld(&ctl[XL_GEN(x)]) == gen, ctl);
        __builtin_amdgcn_fence(__ATOMIC_ACQUIRE, "agent");
        asm volatile("s_waitcnt vmcnt(0)" ::: "memory");
    }
    __syncthreads();
}

enum { PH_GEMM = 0, PH_ROW = 1, PH_CONV = 2, PH_ATTN = 3, PH_PRO = 4 };
struct Phase {
    int type, sync;
    const bf16_t* A; const bf16_t* Bt; int Mg, Ng, Kg, mode, ldc; bf16_t* O; bf16_t* O2;
    const float* base; const float* g; float coef; float* outH; bf16_t* XN; int useF;
};
constexpr int NPHASE = 23;
__device__ __forceinline__ Phase get_phase(const Params& p, int ph) {
    unsigned char* ws = p.ws;
    bf16_t* XN = (bf16_t*)(ws + WS_XN); bf16_t* Fb = (bf16_t*)(ws + WS_F); bf16_t* HB = (bf16_t*)(ws + WS_HB);
    bf16_t* Ub = HB; bf16_t* Bg = HB + (size_t)M * D; bf16_t* Qb = HB; bf16_t* Ob = HB + (size_t)M * D;
    bf16_t* Kb = (bf16_t*)(ws + WS_K); bf16_t* Vt = (bf16_t*)(ws + WS_VT);
    const bf16_t* Wgu = (const bf16_t*)(ws + WS_WGU); const bf16_t* Wdn = (const bf16_t*)(ws + WS_WDN);
    const float* ng = p.in[3];
    Phase q; q.type = PH_GEMM; q.sync = 2; q.A = XN; q.Bt = Wgu; q.Mg = M; q.Ng = 2 * FF; q.Kg = D; q.mode = 1; q.ldc = FF; q.O = HB; q.O2 = nullptr;
    q.base = nullptr; q.g = ng; q.coef = 0.5f; q.outH = nullptr; q.XN = XN; q.useF = 1;
#define GU(j)  do { q.Bt = Wgu + (size_t)(j) * 2 * FF * D; } while (0)
#define DN(j)  do { q.A = HB; q.Bt = Wdn + (size_t)(j) * D * FF; q.Ng = D; q.Kg = FF; q.mode = 3; q.ldc = D; q.O = Fb; } while (0)
#define ROW(gi, cf) do { q.type = PH_ROW; q.g = ng + (gi) * D; q.coef = (cf); } while (0)
    switch (ph) {
    case 0: q.type = PH_PRO; q.sync = 1; break;
    case 1: GU(0); break;
    case 2: DN(0); break;
    case 3: ROW(1, 0.5f); q.base = p.in[0]; break;
    case 4: q.Bt = (const bf16_t*)(ws + WS_WCIN); q.Ng = 3 * D; q.mode = 2; q.ldc = D; q.O = Ub; q.O2 = Bg; q.sync = 1; break;
    case 5: q.type = PH_CONV; break;
    case 6: q.A = Kb; q.Bt = (const bf16_t*)(ws + WS_WCOUT); q.Ng = D; q.mode = 3; q.ldc = D; q.O = Fb; break;
    case 7: ROW(3, 1.0f); break;
    case 8: GU(1); break;
    case 9: DN(1); break;
    case 10: ROW(5, 0.5f); q.sync = 1; break;
    case 11: q.Bt = (const bf16_t*)(ws + WS_WK); q.Ng = D; q.mode = 0; q.ldc = D; q.O = Kb; q.sync = 0; break;
    case 12: q.A = (const bf16_t*)(ws + WS_WV); q.Bt = XN; q.Mg = D; q.Ng = M; q.mode = 0; q.ldc = M; q.O = Vt; q.sync = 0; break;
    case 13: GU(2); break;
    case 14: DN(2); break;
    case 15: ROW(6 + 1, 0.5f); break;
    case 16: q.Bt = (const bf16_t*)(ws + WS_WQ); q.Ng = D; q.mode = 0; q.ldc = D; q.O = Qb; q.sync = 1; break;
    case 17: q.type = PH_ATTN; q.sync = 1; break;
    case 18: q.A = Ob; q.Bt = (const bf16_t*)(ws + WS_WO); q.Ng = D; q.mode = 3; q.ldc = D; q.O = Fb; break;
    case 19: ROW(6 + 3, 1.0f); break;
    case 20: GU(3); break;
    case 21: DN(3); break;
    case 22: ROW(6 + 5, 0.5f); q.XN = nullptr; q.outH = p.out; q.sync = 0; break;
    default: q.type = -1; q.sync = 0; break;
    }
#undef GU
#undef DN
#undef ROW
    return q;
}

__global__ void __launch_bounds__(NTHREADS, 2) mega_fwd(Params p) {
    extern __shared__ __attribute__((aligned(16))) unsigned char lds_raw[];
    cg::grid_group grid = cg::this_grid();
    LAS unsigned char* lds = (LAS unsigned char*)lds_raw;
    const int G = gridDim.x, bx = blockIdx.x;
    int vcu = (G % 8 == 0) ? (bx % 8) * (G / 8) + bx / 8 : bx;
    const int NGW = G * NWAVES;
    unsigned char* ws = p.ws;
    volatile LAS unsigned* bst = (volatile LAS unsigned*)(lds + 131072 + 64);
    if (threadIdx.x < 8) bst[threadIdx.x] = 0u;
    __syncthreads();
    XcdBarrier bar = xcd_barrier_post((unsigned*)(ws + WS_CTL), bst);
    int cid = bx; bool localok = false; unsigned myx = 0u;
    {
        unsigned* ctl = (unsigned*)(ws + WS_CTL);
        if (threadIdx.x == 0) {
            const unsigned x = xb_xcc_id();
            const unsigned rank = xb_add(&ctl[XL_RANK(x)], 1u);
            unsigned sp_ = 0u, ok = 0u;
            for (;;) {
                unsigned sum = 0u, good = 0u;
#pragma unroll
                for (unsigned j = 0; j < 16; ++j) { const unsigned c_ = xb_ld(&ctl[XL_RANK(j)]); sum += c_; good += (j < 8u ? (c_ == 32u) : (c_ == 0u)) ? 1u : 0u; }
                if (sum == (unsigned)G) { ok = (good == 16u && G == 256) ? 1u : 0u; break; }
                __builtin_amdgcn_s_sleep(1);
                if (++sp_ > XB_SPIN_CAP) { ok = 0u; break; }
            }
            bst[2] = x; bst[3] = rank; bst[4] = ok;
        }
        __syncthreads();
        myx = bst[2]; const unsigned rank = bst[3]; localok = bst[4] != 0u;
        if (localok) { cid = (int)(myx + 8u * rank); vcu = (int)(myx * 32u + rank); }
    }
    grid.sync();
    for (int ph = 0; ph < NPHASE; ++ph) {
        int tid_ = threadIdx.x; asm volatile("" : "+v"(tid_));
        const int tid = tid_, lane = tid & 63, wave = __builtin_amdgcn_readfirstlane(tid >> 6);
        const int gw = vcu * NWAVES + wave;
        const Phase q = get_phase(p, ph);
        if (q.type == PH_GEMM) {
            pg8::Gemm g{q.A, q.Bt, q.Mg, q.Ng, q.Kg}; pg8::StaticOrder S; S.init(q.Mg, q.Ng, G, cid);
            pg8::Epi E{q.mode, q.O, q.ldc, q.O2, (float*)(ws + WS_PART)};
            pg8::gemm_phase<pg8::Epi, pg8::StaticOrder, true, true>(lds, g, S, E);
            if ((ph == 1 || ph == 8 || ph == 13) && G == 256 && cid >= 128)
                convert_weights(p, lds, ph == 1 ? 3 : ph == 8 ? 1 : 2, (cid - 128) * NWAVES + wave, 128 * NWAVES, wave, lane);
        } else if (q.type == PH_ROW) {
            const int gwl = (vcu & 31) * NWAVES + wave, xr0 = (vcu >> 5) * 2048;
            rowpass(q.base, (const bf16_t*)(ws + WS_XN), (float*)(ws + WS_RINV), (const bf16_t*)(ws + WS_F), (const float*)(ws + WS_PART), q.g, q.coef, q.outH, q.XN,
                    localok ? xr0 + gwl : gw, localok ? xr0 + 2048 : M, localok ? 256 : NGW, lane);
        } else if (q.type == PH_CONV) {
            const bf16_t* HB = (const bf16_t*)(ws + WS_HB);
            const int gwl = (vcu & 31) * NWAVES + wave, xi0 = (vcu >> 5) * 512;
            convpass(HB, HB + (size_t)M * D, p.in[5], (bf16_t*)(ws + WS_K), localok ? xi0 + gwl : gw, localok ? xi0 + 512 : (M / 8) * 2, localok ? 256 : NGW, lane);
        } else if (q.type == PH_ATTN) {
            const float* lp = p.in[10];
            const float d1 = wave_sum(lp[lane] * lp[64 + lane]), d2 = wave_sum(lp[128 + lane] * lp[192 + lane]);
            const float lam = __expf(d1) - __expf(d2) + LAMBDA_INIT;
            bf16_t* HB = (bf16_t*)(ws + WS_HB);
            for (int v = vcu; v < 256; v += G) {
                const int xcd = v >> 5, j = v & 31;
                att::AttnPre cur, nxt;
                att::attn_prefetch(cur, xcd >> 1, (xcd & 1), j, HB, (const bf16_t*)(ws + WS_K), (const bf16_t*)(ws + WS_VT));
                for (int i = 0; i < 4; ++i) {
                    const int b = xcd >> 1, h = 2 * i + (xcd & 1);
                    const float slope2 = exp2f(-(float)(h + 1)) * LOG2E;
                    const int qb = (i & 1) ? 31 - j : j;
                    const int h1 = 2 * (i + 1) + (xcd & 1), qb1 = ((i + 1) & 1) ? 31 - j : j;
                    att::attn_unit(b, h, qb, HB, (const bf16_t*)(ws + WS_K), (const bf16_t*)(ws + WS_VT), HB + (size_t)M * D, lds, lam, slope2, cur, i < 3, b, h1 & 7, qb1, nxt);
                    cur = nxt;
                }
            }
        } else if (q.type == PH_PRO) {
            convert_weights(p, lds, 0, gw, NGW, wave, lane);
            if (G != 256) { convert_weights(p, lds, 3, gw, NGW, wave, lane); convert_weights(p, lds, 1, gw, NGW, wave, lane); convert_weights(p, lds, 2, gw, NGW, wave, lane); }
            rowpass(p.in[0], nullptr, (float*)(ws + WS_RINV), nullptr, nullptr, nullptr, 0.f, nullptr, (bf16_t*)(ws + WS_XN), gw, M, NGW, lane);
        }
        if (q.sync == 1 || (q.sync == 2 && !localok)) xcd_barrier(bar); else if (q.sync == 2) xcd_local_barrier((unsigned*)(ws + WS_CTL), myx);
    }
}

extern "C" void kernel_launch(void* const* d_in, const int* in_sizes, int n_in, void* d_out, int out_size, void* d_ws, size_t ws_size, hipStream_t stream) {
    static int grid = 0;
    if (grid == 0) {
        if (n_in != 13 || in_sizes[0] != M * D || out_size != M * D || ws_size < WS_END) {
            fprintf(stderr, "kernel_launch: unexpected shapes (n_in %d, in0 %d, out %d, ws %zu); nothing launched\n", n_in, n_in > 0 ? in_sizes[0] : -1, out_size, ws_size); grid = -1; return; }
        int dev = 0, cus = 0, per_cu = 0;
        (void)hipGetDevice(&dev);
        (void)hipDeviceGetAttribute(&cus, hipDeviceAttributeMultiprocessorCount, dev);
        if (hipFuncSetAttribute((const void*)mega_fwd, hipFuncAttributeMaxDynamicSharedMemorySize, LDS_BYTES) != hipSuccess) { fprintf(stderr, "kernel_launch: hipFuncSetAttribute failed\n"); grid = -1; return; }
        if (hipOccupancyMaxActiveBlocksPerMultiprocessor(&per_cu, (const void*)mega_fwd, NTHREADS, LDS_BYTES) != hipSuccess || per_cu < 1) per_cu = 1;
        (void)hipGetLastError();
        grid = cus * per_cu;
        if (grid > 256) grid = 256;
    }
    if (grid < 0) return;
    if (hipMemsetAsync((char*)d_ws + WS_CTL, 0, CTL_BYTES, stream) != hipSuccess) { fprintf(stderr, "kernel_launch: hipMemsetAsync failed\n"); return; }
    Params p{};
    for (int i = 0; i < 13; ++i) p.in[i] = (const float*)d_in[i];
    p.out = (float*)d_out; p.ws = (unsigned char*)d_ws;
    void* args[] = {&p};
    hipError_t e = hipLaunchCooperativeKernel((const void*)mega_fwd, dim3(grid), dim3(NTHREADS), args, LDS_BYTES, stream);
    if (e != hipSuccess) fprintf(stderr, "cooperative launch failed: %s (grid %d)\n", hipGetErrorString(e), grid);
}
```

```cpp
#include <hip/hip_runtime.h>
#include <hip/hip_cooperative_groups.h>
#include <cstdio>
#include <cstdint>
#include <cmath>
namespace cg = cooperative_groups;
namespace pg8 {
#define PG8_LAS __attribute__((address_space(3)))
typedef unsigned short bf16_t;
typedef short bf16x8 __attribute__((ext_vector_type(8)));
typedef float f32x4 __attribute__((ext_vector_type(4)));
typedef unsigned u32x4 __attribute__((ext_vector_type(4)));
constexpr int BM = 256, BK = 64, HALF = 128, HTB = HALF * BK * 2  , STAGE_BYTES = 8 * HTB, NXCD = 8, WGM = 4;

__host__ __device__ __forceinline__ int lds_byte(int r, int c) { const int st = (r >> 4) * 2 + (c >> 5), rr = r & 15, cc = c & 31, ob = rr * 64 + cc * 2; return st * 1024 + (ob ^ (((ob >> 9) & 1) << 5)); }
__host__ __device__ __forceinline__ void stage_rc(int b, int& R, int& C) { const int st = b / 1024, sb = b % 1024, swz = sb ^ (((sb >> 9) & 1) << 5); R = (st >> 1) * 16 + swz / 64; C = (st & 1) * 32 + (swz % 64) / 2; }
__host__ __device__ __forceinline__ int perm32(int rho) { const int n = rho >> 4, i = rho & 15; return 8 * (i >> 2) + 4 * n + (i & 3); }

struct Unit { int pm, pn; };
struct Gemm { const bf16_t* A; const bf16_t* Bt; int M, N, K; };

struct StaticOrder {
    int nM, nN, nwg, G, c;
    __host__ __device__ void init(int M, int N, int G_, int c_) { nM = M / BM; nN = N / BM; nwg = nM * nN; G = G_; c = c_; }
    __host__ __device__ bool next(int i, Unit& u) const {
        const long L = (long)i * G + c; if (L >= nwg) return false;
        int wgid = (int)L; { const int q = nwg / NXCD, r = nwg % NXCD, xcd = wgid % NXCD, off = wgid / NXCD; wgid = (xcd < r ? xcd * (q + 1) : r * (q + 1) + (xcd - r) * q) + off; }
        const int nig = WGM * nN, gid = wgid / nig, fm = gid * WGM, gsz = (nM - fm) < WGM ? (nM - fm) : WGM;
        u.pm = fm + ((wgid % nig) % gsz); u.pn = (wgid % nig) / gsz; return true;
    }
    __device__ __forceinline__ void a_ready(const Unit&) const {}
    __device__ __forceinline__ void done(const Unit&) const {}
};

typedef float f32x2c_t __attribute__((ext_vector_type(2))); typedef __bf16 bf16x2c_t __attribute__((ext_vector_type(2)));
__device__ __forceinline__ unsigned cvt_pk_bf16(float lo, float hi) { f32x2c_t v = {lo, hi}; bf16x2c_t b = __builtin_convertvector(v, bf16x2c_t); return __builtin_bit_cast(unsigned, b); }
typedef float f32x2 __attribute__((ext_vector_type(2)));
__device__ __forceinline__ float silu_f(float v) { return v * __builtin_amdgcn_rcpf(1.0f + __builtin_amdgcn_exp2f(-1.4426950408889634f * v)); }
struct Epi {
    static constexpr bool PERM = true, AFTER_DRAIN = false;
    int mode; bf16_t* O; int ldc; bf16_t* O2; float* part;
    __device__ __forceinline__ void st8(bf16_t* p, const f32x4 v0, const f32x4 v1) const {
        u32x4 w; w.x = cvt_pk_bf16(v0[0], v0[1]); w.y = cvt_pk_bf16(v0[2], v0[3]); w.z = cvt_pk_bf16(v1[0], v1[1]); w.w = cvt_pk_bf16(v1[2], v1[3]);
        *(u32x4*)p = w;
    }
    __device__ __forceinline__ void operator()(const f32x4 (&acc)[2][2][4][2], const Unit& u, int wr, int wc, int fr, int fq) const {
        const int row0 = u.pm * BM + wr * 64 + fr;
        if (mode == 1 || (mode == 2 && u.pn < 8)) {
            const int col0 = u.pn * HALF + wc * 32 + 8 * fq;
#pragma unroll
            for (int ai = 0; ai < 2; ++ai)
#pragma unroll
                for (int m = 0; m < 4; ++m) {
                    bf16_t* rowp = O + (size_t)(row0 + ai * HALF + m * 16) * ldc + col0;
                    f32x4 a0 = acc[ai][0][m][0], a1 = acc[ai][0][m][1]; const f32x4 b0 = acc[ai][1][m][0], b1 = acc[ai][1][m][1];
                    if (mode == 1) {
#pragma unroll
                        for (int e = 0; e < 4; ++e) { a0[e] = silu_f(a0[e]); a1[e] = silu_f(a1[e]); }
                    }
                    st8(rowp, a0 * b0, a1 * b1);
                }
        } else {
            bf16_t* base = O; int colt = u.pn * BM;
            if (mode == 2) { base = O2; colt -= 8 * BM; }
            const int col0 = colt + wc * 32 + 8 * fq;
#pragma unroll
            for (int ai = 0; ai < 2; ++ai)
#pragma unroll
                for (int m = 0; m < 4; ++m) {
                    bf16_t* rowp = base + (size_t)(row0 + ai * HALF + m * 16) * ldc + col0;
#pragma unroll
                    for (int bj = 0; bj < 2; ++bj) st8(rowp + bj * HALF, acc[ai][bj][m][0], acc[ai][bj][m][1]);
                    if (mode == 3) {
                        float s = 0.f;
#pragma unroll
                        for (int bj = 0; bj < 2; ++bj)
#pragma unroll
                            for (int n = 0; n < 2; ++n) { const f32x4 x = acc[ai][bj][m][n]; s += (x[0] * x[0] + x[1] * x[1]) + (x[2] * x[2] + x[3] * x[3]); }
                        s += __shfl_xor(s, 16); s += __shfl_xor(s, 32);
                        if (fq == 0) part[(size_t)(row0 + ai * HALF + m * 16) * 16 + u.pn * 4 + wc] = s;
                    }
                }
        }
    }
};

template <class Epi, class Sched, bool ALIGN_EPI = false, bool SP2 = false>
__device__ __forceinline__ void gemm_phase(PG8_LAS unsigned char* lds, const Gemm g, const Sched& S, const Epi& E) {
    int tid_ = threadIdx.x; asm volatile("" : "+v"(tid_));
    const int tid = tid_, wid = __builtin_amdgcn_readfirstlane(tid >> 6), lane = tid & 63, wr = wid >> 2, wc = wid & 3, fr = lane & 15, fq = lane >> 4;
    const int K = g.K, nt = K / BK;
    unsigned voffA[2], voffB[2];
#pragma unroll
    for (int i = 0; i < 2; ++i) { int R, C; stage_rc(tid * 16 + i * 8192, R, C); const int Rb = Epi::PERM ? ((R & ~31) + perm32(R & 31)) : R;
        voffA[i] = (unsigned)(R * K + C) * 2u; voffB[i] = (unsigned)(Rb * K + C) * 2u; }
    const size_t kstep = (size_t)(BK * 2);
    const size_t hstep = (size_t)HALF * K * 2;
    const size_t tstep = 2 * hstep;
    const unsigned ldsw = (unsigned)wid * 1024u;
    const int aoff = lds_byte(wr * 64 + fr, fq * 8), boff = lds_byte(wc * 32 + fr, fq * 8);
#define PG8_SA(b, h) (((b) * 2 + (h)) * HTB)
#define PG8_SB(b, h) ((4 + (b) * 2 + (h)) * HTB)
#define PG8_STAGE(bufoff, gbase, voff) do { _Pragma("unroll") for (int _i = 0; _i < 2; ++_i) \
        __builtin_amdgcn_global_load_lds((const unsigned*)((const char*)(gbase) + (voff)[_i]), (PG8_LAS unsigned*)(lds + (bufoff) + ldsw + _i * 8192), 16, 0, 0); } while (0)
#define PG8_LDA(dst, b, h) do { _Pragma("unroll") for (int m = 0; m < 4; ++m) _Pragma("unroll") for (int k = 0; k < 2; ++k) dst[m][k] = *(const PG8_LAS bf16x8*)(lds + PG8_SA(b, h) + aoff + m * 2048 + k * 1024); } while (0)
#define PG8_LDB(dst, b, h) do { _Pragma("unroll") for (int n = 0; n < 2; ++n) _Pragma("unroll") for (int k = 0; k < 2; ++k) dst[n][k] = *(const PG8_LAS bf16x8*)(lds + PG8_SB(b, h) + boff + n * 2048 + k * 1024); } while (0)
#define PG8_MMA(ai, bj, At, Bt) do { __builtin_amdgcn_s_setprio(1); _Pragma("unroll") for (int m = 0; m < 4; ++m) _Pragma("unroll") for (int n = 0; n < 2; ++n) _Pragma("unroll") for (int k = 0; k < 2; ++k) \
        acc[ai][bj][m][n] = __builtin_amdgcn_mfma_f32_16x16x32_bf16(Bt[n][k], At[m][k], acc[ai][bj][m][n], 0, 0, 0); __builtin_amdgcn_s_setprio(0); } while (0)
#define PG8_WAIT_V(n) asm volatile("s_waitcnt vmcnt(" #n ")" ::: "memory")
#define PG8_WAIT_L(n) asm volatile("s_waitcnt lgkmcnt(" #n ")" ::: "memory")
#define PG8_BAR __builtin_amdgcn_s_barrier()
#define PG8_SCHED __builtin_amdgcn_sched_barrier(0)
    Unit cur, nxt; int ui = 0;
    if (!S.next(0, cur)) return;
    f32x4 acc[2][2][4][2];
#pragma unroll
    for (int a = 0; a < 2; ++a)
#pragma unroll
        for (int b = 0; b < 2; ++b)
#pragma unroll
            for (int m = 0; m < 4; ++m)
#pragma unroll
                for (int n = 0; n < 2; ++n) acc[a][b][m][n] = (f32x4){0.f, 0.f, 0.f, 0.f};
    bf16x8 At[4][2], B0[2][2], B1[2][2];
    const char* cA = (const char*)g.A + (size_t)cur.pm * tstep; const char* cB = (const char*)g.Bt + (size_t)cur.pn * tstep;
    S.a_ready(cur);
    if constexpr (SP2) {
        PG8_STAGE(PG8_SB(0, 0), cB, voffB); PG8_STAGE(PG8_SB(0, 1), cB + hstep, voffB); PG8_STAGE(PG8_SA(0, 0), cA, voffA); PG8_STAGE(PG8_SA(0, 1), cA + hstep, voffA);
        if (wr == 1) PG8_BAR;
        PG8_WAIT_V(2); PG8_BAR;
        PG8_STAGE(PG8_SB(1, 0), cB + kstep, voffB); PG8_STAGE(PG8_SA(1, 0), cA + kstep, voffA); PG8_STAGE(PG8_SB(1, 1), cB + hstep + kstep, voffB);
        PG8_WAIT_V(6); PG8_BAR;
    } else {
        PG8_STAGE(PG8_SB(0, 0), cB, voffB); PG8_STAGE(PG8_SA(0, 0), cA, voffA); PG8_STAGE(PG8_SB(0, 1), cB + hstep, voffB); PG8_STAGE(PG8_SA(0, 1), cA + hstep, voffA);
        if (wr == 1) PG8_BAR;
        PG8_WAIT_V(4); PG8_BAR;
        PG8_STAGE(PG8_SB(1, 0), cB + kstep, voffB); PG8_STAGE(PG8_SA(1, 0), cA + kstep, voffA); PG8_STAGE(PG8_SB(1, 1), cB + hstep + kstep, voffB);
        PG8_WAIT_V(6); PG8_BAR;
    }
    for (;;) {
        const bool has_next = S.next(ui + 1, nxt);
        const char* nA = has_next ? (const char*)g.A + (size_t)nxt.pm * tstep : cA; const char* nB = has_next ? (const char*)g.Bt + (size_t)nxt.pn * tstep : cB;
        for (int t = 0; t < nt; t += 2) {
            const bool last = (t == nt - 2);
            const char* a1 = cA + (size_t)(t + 1) * kstep;
            const char* a2 = last ? nA : cA + (size_t)(t + 2) * kstep; const char* b2 = last ? nB : cB + (size_t)(t + 2) * kstep;
            const char* a3 = a2 + kstep; const char* b3 = b2 + kstep;
            if (last && has_next) S.a_ready(nxt);
            if constexpr (SP2) {
            PG8_LDB(B0, 0, 0); PG8_LDB(B1, 0, 1); PG8_SCHED; PG8_LDA(At, 0, 0); PG8_STAGE(PG8_SA(1, 1), a1 + hstep, voffA);
            PG8_WAIT_V(8); PG8_WAIT_L(0); PG8_BAR; PG8_MMA(0, 0, At, B0); PG8_MMA(0, 1, At, B1); PG8_BAR; PG8_SCHED;
            PG8_LDA(At, 0, 1); PG8_STAGE(PG8_SB(0, 0), b2, voffB); PG8_STAGE(PG8_SB(0, 1), b2 + hstep, voffB); PG8_STAGE(PG8_SA(0, 0), a2, voffA);
            PG8_WAIT_V(8); PG8_WAIT_L(0); PG8_BAR; PG8_MMA(1, 0, At, B0); PG8_MMA(1, 1, At, B1); PG8_BAR; PG8_SCHED;
            PG8_LDB(B0, 1, 0); PG8_LDB(B1, 1, 1); PG8_SCHED; PG8_LDA(At, 1, 0); PG8_STAGE(PG8_SA(0, 1), a2 + hstep, voffA);
            PG8_WAIT_V(8); PG8_WAIT_L(0); PG8_BAR; PG8_MMA(0, 0, At, B0); PG8_MMA(0, 1, At, B1); PG8_BAR; PG8_SCHED;
            PG8_LDA(At, 1, 1); PG8_STAGE(PG8_SB(1, 0), b3, voffB); PG8_STAGE(PG8_SB(1, 1), b3 + hstep, voffB); PG8_STAGE(PG8_SA(1, 0), a3, voffA);
            PG8_WAIT_V(8); PG8_WAIT_L(0); PG8_BAR; PG8_MMA(1, 0, At, B0); PG8_MMA(1, 1, At, B1); PG8_BAR; PG8_SCHED;
            } else {
            PG8_LDB(B0, 0, 0); PG8_SCHED; PG8_LDA(At, 0, 0); PG8_STAGE(PG8_SA(1, 1), a1 + hstep, voffA);
            PG8_WAIT_L(8); PG8_BAR; PG8_WAIT_L(0); PG8_MMA(0, 0, At, B0); PG8_BAR; PG8_SCHED;
            PG8_LDB(B1, 0, 1); PG8_STAGE(PG8_SB(0, 0), b2, voffB);
            PG8_BAR; PG8_WAIT_L(0); PG8_MMA(0, 1, At, B1); PG8_BAR;
            PG8_LDA(At, 0, 1); PG8_STAGE(PG8_SA(0, 0), a2, voffA);
            PG8_BAR; PG8_WAIT_L(0); PG8_MMA(1, 0, At, B0); PG8_BAR; PG8_SCHED;
            PG8_STAGE(PG8_SB(0, 1), b2 + hstep, voffB);
            PG8_WAIT_V(6); PG8_BAR; PG8_MMA(1, 1, At, B1); PG8_BAR;
            PG8_LDB(B0, 1, 0); PG8_SCHED; PG8_LDA(At, 1, 0); PG8_STAGE(PG8_SA(0, 1), a2 + hstep, voffA);
            PG8_WAIT_L(8); PG8_BAR; PG8_WAIT_L(0); PG8_MMA(0, 0, At, B0); PG8_BAR; PG8_SCHED;
            PG8_LDB(B1, 1, 1); PG8_STAGE(PG8_SB(1, 0), b3, voffB);
            PG8_BAR; PG8_WAIT_L(0); PG8_MMA(0, 1, At, B1); PG8_BAR;
            PG8_LDA(At, 1, 1); PG8_STAGE(PG8_SA(1, 0), a3, voffA);
            PG8_BAR; PG8_WAIT_L(0); PG8_MMA(1, 0, At, B0); PG8_BAR; PG8_SCHED;
            PG8_STAGE(PG8_SB(1, 1), b3 + hstep, voffB);
            PG8_WAIT_V(6); PG8_BAR; PG8_MMA(1, 1, At, B1); PG8_BAR;
            }
        }
        if constexpr (ALIGN_EPI) { if (wr == 0) PG8_BAR; }
        if constexpr (!Epi::AFTER_DRAIN) { E(acc, cur, wr, wc, fr, fq); S.done(cur); }
        if (!has_next) break;
#pragma unroll
        for (int a = 0; a < 2; ++a)
#pragma unroll
            for (int b = 0; b < 2; ++b)
#pragma unroll
                for (int m = 0; m < 4; ++m)
#pragma unroll
                    for (int n = 0; n < 2; ++n) acc[a][b][m][n] = (f32x4){0.f, 0.f, 0.f, 0.f};
        cur = nxt; cA = nA; cB = nB; ++ui;
        if constexpr (ALIGN_EPI) { if (wr == 1) PG8_BAR; }
    }
    PG8_WAIT_V(0);
    if constexpr (!ALIGN_EPI) { if (wr == 0) PG8_BAR; }
    PG8_BAR;
    if constexpr (Epi::AFTER_DRAIN) { E.fused(acc, cur, wr, wc, fr, fq, lds, wid, lane); S.done(cur); }
#undef PG8_SA
#undef PG8_SB
#undef PG8_STAGE
#undef PG8_LDA
#undef PG8_LDB
#undef PG8_MMA
#undef PG8_WAIT_V
#undef PG8_WAIT_L
#undef PG8_BAR
#undef PG8_SCHED
}
}

#define LAS __attribute__((address_space(3)))
typedef unsigned short bf16_t;
typedef short bf16x8 __attribute__((ext_vector_type(8)));
typedef float f32x4 __attribute__((ext_vector_type(4)));
typedef float f32x16 __attribute__((ext_vector_type(16)));
typedef unsigned u32x4 __attribute__((ext_vector_type(4)));
typedef unsigned u32x2 __attribute__((ext_vector_type(2)));
constexpr int D = 1024, SEQ = 4096, NB = 4, M = NB * SEQ, FF = 2816, NH = 8;
constexpr float EPS = 1e-6f;
constexpr float LOG2E = 1.4426950408889634f;
constexpr float LAMBDA_INIT = 0.35550906759096926f;
constexpr int NWAVES = 8, NTHREADS = 512;
constexpr int LDS_BYTES = 135168;

constexpr size_t MiB = 1u << 20;
constexpr size_t WS_PART = 0;
constexpr size_t WS_WGU = 1 * MiB;
constexpr size_t WS_WDN = 45 * MiB;
constexpr size_t WS_WCIN = 67 * MiB, WS_WCOUT = 73 * MiB, WS_WK = 75 * MiB, WS_WV = 77 * MiB, WS_WQ = 79 * MiB, WS_WO = 81 * MiB;
constexpr size_t WS_XN = 83 * MiB;
constexpr size_t WS_F = 115 * MiB;
constexpr size_t WS_K = 147 * MiB;
constexpr size_t WS_VT = 179 * MiB;
constexpr size_t WS_HB = 211 * MiB;
constexpr size_t WS_CTL = 299 * MiB, CTL_BYTES = 65536;
constexpr size_t WS_RINV = 300 * MiB;
constexpr size_t WS_END = 301 * MiB;

__device__ __forceinline__ unsigned f2bf(float f) { unsigned u = __builtin_bit_cast(unsigned, f); return (u + 0x7fffu + ((u >> 16) & 1u)) >> 16; }
__device__ __forceinline__ unsigned pk2(float lo, float hi) { return f2bf(lo) | (f2bf(hi) << 16); }
__device__ __forceinline__ float bflo(unsigned w) { return __builtin_bit_cast(float, w << 16); }
__device__ __forceinline__ float bfhi(unsigned w) { return __builtin_bit_cast(float, w & 0xffff0000u); }
__device__ __forceinline__ float wave_sum(float v) {
#pragma unroll
    for (int o = 1; o < 64; o <<= 1) v += __shfl_xor(v, o);
    return v;
}

__device__ __forceinline__ void transpose_item(const float* W, int K, int Nsrc, bf16_t* WT, int nrows, int mapmode, int off, const float* gk, int gmask, float gscale,
                                               LAS float* scr, int item, int lane) {
    const int nblk = nrows / 32, kb = item / nblk, nb = item % nblk, k0 = 64 * kb, n0 = 32 * nb;
    int c0;
    if (mapmode == 0) c0 = off + n0;
    else if (mapmode == 1) { const int pn = n0 >> 8, j = n0 & 255; c0 = (j >> 7) * FF + pn * 128 + (j & 127); }
    else { if (n0 < 2048) { const int pn = n0 >> 8, j = n0 & 255; c0 = 1024 + (j >> 7) * 1024 + pn * 128 + (j & 127); } else c0 = n0 - 2048; }
    float wv[32];
    const float* wp = W + (size_t)(k0 + (lane >> 5)) * Nsrc + c0 + (lane & 31);
#pragma unroll
    for (int i = 0; i < 32; ++i) wv[i] = wp[(size_t)(2 * i) * Nsrc];
    const int c = lane & 7;
    float gs[8];
#pragma unroll
    for (int e = 0; e < 8; ++e) gs[e] = gk ? gk[(k0 + 8 * c + e) & gmask] * gscale : gscale;
#pragma unroll
    for (int i = 0; i < 32; ++i) scr[(2 * i + (lane >> 5)) * 33 + (lane & 31)] = wv[i];
    asm volatile("s_waitcnt lgkmcnt(0)" ::: "memory");
#pragma unroll
    for (int j = 0; j < 4; ++j) { const int n = (lane >> 3) + 8 * j; const LAS float* s = scr + (8 * c) * 33 + n;
        u32x4 o; o.x = pk2(s[0 * 33] * gs[0], s[1 * 33] * gs[1]); o.y = pk2(s[2 * 33] * gs[2], s[3 * 33] * gs[3]); o.z = pk2(s[4 * 33] * gs[4], s[5 * 33] * gs[5]); o.w = pk2(s[6 * 33] * gs[6], s[7 * 33] * gs[7]);
        *(u32x4*)(WT + (size_t)(n0 + n) * K + k0 + 8 * c) = o; }
    asm volatile("s_waitcnt lgkmcnt(0)" ::: "memory");
}

struct Params { const float* in[13]; float* out; unsigned char* ws; };

__device__ __forceinline__ void convert_weights(const Params& p, LAS unsigned char* lds, int which, int w0, int wstride, int wave, int lane) {
    LAS float* scr = (LAS float*)(lds + wave * 16384);
    constexpr int I_GU = (D / 64) * (2 * FF / 32), I_DN = (FF / 64) * (D / 32), I_CIN = (D / 64) * (3 * D / 32), I_SQ = (D / 64) * (D / 32);
    unsigned char* ws = p.ws;
    const int nitems = (which == 0) ? I_GU + I_DN + I_CIN + I_SQ : (which == 1) ? 3 * I_SQ + I_GU + I_DN : (which == 2) ? I_SQ + I_GU + I_DN : I_GU + I_DN;
#define TGU(j, r) transpose_item(p.in[1] + (size_t)(j) * D * 2 * FF, D, 2 * FF, (bf16_t*)(ws + WS_WGU) + (size_t)(j) * 2 * FF * D, 2 * FF, 1, 0, p.in[3] + (((j) >> 1) * 6 + (((j) & 1) ? 4 : 0)) * D, D - 1, 1.f, scr, r, lane)
#define TDN(j, r) transpose_item(p.in[2] + (size_t)(j) * FF * D, FF, D, (bf16_t*)(ws + WS_WDN) + (size_t)(j) * D * FF, D, 0, 0, nullptr, 0, 1.f, scr, r, lane)
    for (int it = w0; it < nitems; it += wstride) {
        int r = it;
        if (which == 3) { if (r < I_GU) { TGU(1, r); continue; } r -= I_GU; TDN(1, r); continue; }
        if (which == 0) {
            if (r < I_GU) { TGU(0, r); continue; }
            r -= I_GU;
            if (r < I_DN) { TDN(0, r); continue; }
            r -= I_DN;
            if (r < I_CIN) { transpose_item(p.in[4], D, 3 * D, (bf16_t*)(ws + WS_WCIN), 3 * D, 2, 0, p.in[3] + 2 * D, D - 1, 1.f, scr, r, lane); continue; }
            r -= I_CIN;
            transpose_item(p.in[6], D, D, (bf16_t*)(ws + WS_WCOUT), D, 0, 0, nullptr, 0, 1.f, scr, r, lane);
        } else if (which == 1) {
            if (r < I_SQ) { transpose_item(p.in[8], D, 2 * D, (bf16_t*)(ws + WS_WK), D, 0, 0, p.in[7], D - 1, 1.f, scr, r, lane); continue; }
            r -= I_SQ;
            if (r < I_SQ) { transpose_item(p.in[8], D, 2 * D, (bf16_t*)(ws + WS_WV), D, 0, D, p.in[7], D - 1, 1.f, scr, r, lane); continue; }
            r -= I_SQ;
            if (r < I_GU) { TGU(2, r); continue; }
            r -= I_GU;
            if (r < I_DN) { TDN(2, r); continue; }
            r -= I_DN;
            transpose_item(p.in[9], D, D, (bf16_t*)(ws + WS_WQ), D, 0, 0, p.in[3] + (6 + 2) * D, D - 1, 0.125f * LOG2E, scr, r, lane);
        } else {
            if (r < I_SQ) { transpose_item(p.in[12], D, D, (bf16_t*)(ws + WS_WO), D, 0, 0, p.in[11], 127, 1.0f - LAMBDA_INIT, scr, r, lane); continue; }
            r -= I_SQ;
            if (r < I_GU) { TGU(3, r); continue; }
            r -= I_GU;
            TDN(3, r);
        }
    }
#undef TGU
#undef TDN
}

__device__ __forceinline__ void rowpass(const float* base, const bf16_t* Xp, float* rinv, const bf16_t* F, const float* part, const float* g, float coef, float* outF, bf16_t* XN, int r0, int rend, int rstride, int lane) {
    f32x4 gg[4];
#pragma unroll
    for (int j = 0; j < 4; ++j) gg[j] = F ? ((const f32x4*)g)[lane + 64 * j] : (f32x4){0.f, 0.f, 0.f, 0.f};
    f32x4 hb[4]; u32x2 xb[4], fb[4]; float ps = 0.f, ri = 0.f;
#define RP_LOAD(mm, H_, X_, F_, P_, R_) do { \
        if (base) { const f32x4* br_ = (const f32x4*)(base + (size_t)(mm) * D) + lane; _Pragma("unroll") for (int j = 0; j < 4; ++j) H_[j] = br_[64 * j]; } \
        else { const u32x2* xr_ = (const u32x2*)(Xp + (size_t)(mm) * D) + lane; _Pragma("unroll") for (int j = 0; j < 4; ++j) X_[j] = xr_[64 * j]; R_ = rinv[(mm)]; } \
        if (F) { const u32x2* fr_ = (const u32x2*)(F + (size_t)(mm) * D) + lane; _Pragma("unroll") for (int j = 0; j < 4; ++j) F_[j] = fr_[64 * j]; \
                 P_ = (lane < 16) ? part[(size_t)(mm) * 16 + lane] : 0.f; } } while (0)
#pragma unroll
    for (int j = 0; j < 4; ++j) { fb[j] = (u32x2){0u, 0u}; xb[j] = (u32x2){0u, 0u}; hb[j] = (f32x4){0.f, 0.f, 0.f, 0.f}; }
    if (r0 < rend) RP_LOAD(r0, hb, xb, fb, ps, ri);
    for (int m = r0; m < rend; m += rstride) {
        f32x4 hn[4]; u32x2 xn[4], fn[4]; float pn = 0.f, rn = 0.f;
#pragma unroll
        for (int j = 0; j < 4; ++j) { hn[j] = (f32x4){0.f, 0.f, 0.f, 0.f}; fn[j] = (u32x2){0u, 0u}; xn[j] = (u32x2){0u, 0u}; }
        if (m + rstride < rend) RP_LOAD(m + rstride, hn, xn, fn, pn, rn);
        f32x4 v[4]; float s = 0.f;
#pragma unroll
        for (int j = 0; j < 4; ++j) v[j] = base ? hb[j] : (f32x4){bflo(xb[j].x), bfhi(xb[j].x), bflo(xb[j].y), bfhi(xb[j].y)} * ri;
        if (F) {
            const float rF = coef / sqrtf(wave_sum(ps) * (1.0f / D) + EPS);
#pragma unroll
            for (int j = 0; j < 4; ++j) { const u32x2 f = fb[j];
                const f32x4 fv = (f32x4){bflo(f.x), bfhi(f.x), bflo(f.y), bfhi(f.y)};
                v[j] = v[j] + fv * gg[j] * rF; }
        }
        if (outF) { f32x4* orow = (f32x4*)(outF + (size_t)m * D) + lane;
#pragma unroll
            for (int j = 0; j < 4; ++j) orow[64 * j] = v[j]; }
        if (XN) {
#pragma unroll
            for (int j = 0; j < 4; ++j) s += (v[j].x * v[j].x + v[j].y * v[j].y) + (v[j].z * v[j].z + v[j].w * v[j].w);
            const float ms = wave_sum(s) * (1.0f / D) + EPS, rstd = 1.0f / sqrtf(ms);
            u32x2* xo = (u32x2*)(XN + (size_t)m * D) + lane;
#pragma unroll
            for (int j = 0; j < 4; ++j) { u32x2 w; w.x = pk2(v[j].x * rstd, v[j].y * rstd); w.y = pk2(v[j].z * rstd, v[j].w * rstd); xo[64 * j] = w; }
            if (lane == 0) rinv[m] = sqrtf(ms);
        }
#pragma unroll
        for (int j = 0; j < 4; ++j) { hb[j] = hn[j]; fb[j] = fn[j]; xb[j] = xn[j]; }
        ps = pn; ri = rn;
    }
#undef RP_LOAD
}

__device__ __forceinline__ void unpack8(const u32x4 w, float (&f)[8]) { f[0] = bflo(w.x); f[1] = bfhi(w.x); f[2] = bflo(w.y); f[3] = bfhi(w.y); f[4] = bflo(w.z); f[5] = bfhi(w.z); f[6] = bflo(w.w); f[7] = bfhi(w.w); }
__device__ __forceinline__ void convpass(const bf16_t* U, const bf16_t* Bg, const float* ck, bf16_t* Y, int i0, int iend, int istride, int lane) {
    constexpr int RCH = 8, NITEM = (M / RCH) * 2;
    for (int it = i0; it < iend; it += istride) {
        const int rc = it >> 1, hh = it & 1, col = hh * 512 + lane * 8, t0 = rc * RCH;
        u32x4 ur[RCH + 2], br[RCH];
        const bool head = (t0 & (SEQ - 1)) == 0;
        ur[0] = head ? (u32x4){0u, 0u, 0u, 0u} : *(const u32x4*)(U + (size_t)(t0 - 2) * D + col);
        ur[1] = head ? (u32x4){0u, 0u, 0u, 0u} : *(const u32x4*)(U + (size_t)(t0 - 1) * D + col);
#pragma unroll
        for (int i = 0; i < RCH; ++i) { ur[i + 2] = *(const u32x4*)(U + (size_t)(t0 + i) * D + col); br[i] = *(const u32x4*)(Bg + (size_t)(t0 + i) * D + col); }
        float k0[8], k1[8], k2[8], um2[8], um1[8];
#pragma unroll
        for (int e = 0; e < 8; ++e) { k0[e] = ck[col + e]; k1[e] = ck[D + col + e]; k2[e] = ck[2 * D + col + e]; }
        unpack8(ur[0], um2); unpack8(ur[1], um1);
#pragma unroll
        for (int i = 0; i < RCH; ++i) {
            float u[8], b[8], y[8];
            unpack8(ur[i + 2], u); unpack8(br[i], b);
#pragma unroll
            for (int e = 0; e < 8; ++e) { y[e] = b[e] * (k0[e] * um2[e] + k1[e] * um1[e] + k2[e] * u[e]); um2[e] = um1[e]; um1[e] = u[e]; }
            u32x4 w; w.x = pk2(y[0], y[1]); w.y = pk2(y[2], y[3]); w.z = pk2(y[4], y[5]); w.w = pk2(y[6], y[7]);
            *(u32x4*)(Y + (size_t)(t0 + i) * D + col) = w;
        }
    }
}

namespace att {
constexpr int KROW = 72, K_BYTES = 64 * KROW * 2, V_BYTES = 128 * KROW * 2, STAGE = 2 * K_BYTES + V_BYTES;
constexpr int PFD = 1;
constexpr int NSTG = 3;
constexpr int OFF_SCR = NSTG * STAGE;
constexpr int OFF_OST = 65536;
constexpr int OST_ROW = 136;
static_assert(OFF_OST + 4 * 32 * OST_ROW * 2 <= NSTG * STAGE && OFF_SCR + 8 * 256 <= 131072, "attention LDS");
__device__ __forceinline__ float max3f(float a, float b, float c) { float r; asm("v_max3_f32 %0, %1, %2, %3" : "=v"(r) : "v"(a), "v"(b), "v"(c)); return r; }
__device__ __forceinline__ int crow(int r, int hi) { return (r & 3) + 8 * (r >> 2) + 4 * hi; }
__device__ __forceinline__ int swap23(int i) { return (i & ~12) | ((i & 4) << 1) | ((i & 8) >> 1); }
typedef float f32x2_t __attribute__((ext_vector_type(2))); typedef __bf16 bf16x2_t __attribute__((ext_vector_type(2)));
__device__ __forceinline__ unsigned cvtpk(float lo, float hi) { f32x2_t v = {lo, hi}; bf16x2_t b = __builtin_convertvector(v, bf16x2_t); return __builtin_bit_cast(unsigned, b); }

struct AttnPre { bf16x8 qf[4]; u32x4 kr[2], vr[2]; };
__device__ __forceinline__ void attn_prefetch(AttnPre& P, int b, int h, int qb, const bf16_t* Q, const bf16_t* Kb, const bf16_t* Vt) {
    int tid_ = threadIdx.x; asm volatile("" : "+v"(tid_));
    const int tid = tid_, lane = tid & 63, r32 = lane & 31, hi = lane >> 5;
    const int wid = __builtin_amdgcn_readfirstlane(tid >> 6), c = wid >> 2, qs = wid & 3;
    const size_t tok0 = (size_t)b * SEQ;
    const bf16_t* qp = Q + (tok0 + qb * 128 + qs * 32 + r32) * D + h * 128 + c * 64 + hi * 8;
#pragma unroll
    for (int d0 = 0; d0 < 4; ++d0) P.qf[d0] = *(const bf16x8*)(qp + d0 * 16);
#pragma unroll
    for (int i = 0; i < 2; ++i) { const int id = tid + 512 * i;
        { const int row = id >> 4, ch = id & 15; P.kr[i] = *(const u32x4*)(Kb + (tok0 + row) * D + h * 128 + ch * 8); }
        { const int d = id >> 3, ch = id & 7; P.vr[i] = *(const u32x4*)(Vt + (size_t)(h * 128 + d) * M + tok0 + ch * 8); } }
}
__device__ __forceinline__ void attn_unit(int b, int h, int qb, const bf16_t* Q, const bf16_t* Kb, const bf16_t* Vt, bf16_t* O, LAS unsigned char* lds, float lam, float slope2,
                                          const AttnPre& pre, bool hn, int nb, int nh, int nqb, AttnPre& nxt) {
    int tid_ = threadIdx.x; asm volatile("" : "+v"(tid_));
    const int tid = tid_, lane = tid & 63, r32 = lane & 31, hi = lane >> 5;
    const int wid = __builtin_amdgcn_readfirstlane(tid >> 6), c = wid >> 2, qs = wid & 3;
    const int q0w = qb * 128 + qs * 32;
    const size_t tok0 = (size_t)b * SEQ;
    LAS float* scr = (LAS float*)(lds + OFF_SCR) + wid * 64;
    bf16x8 qf[4];
#pragma unroll
    for (int d0 = 0; d0 < 4; ++d0) qf[d0] = pre.qf[d0];
    const bf16_t* kg[2]; const bf16_t* vg[2]; int kl[2], vl[2];
#pragma unroll
    for (int i = 0; i < 2; ++i) { const int id = tid + 512 * i;
        { const int row = id >> 4, ch = id & 15; kg[i] = Kb + (tok0 + row) * D + h * 128 + ch * 8; kl[i] = (ch >> 3) * K_BYTES + (row * KROW + (ch & 7) * 8) * 2; }
        { const int d = id >> 3, ch = id & 7; vg[i] = Vt + (size_t)(h * 128 + d) * M + tok0 + ch * 8; vl[i] = 2 * K_BYTES + (d * KROW + ch * 8) * 2; } }
    const int NT = 2 * qb + 2;
    u32x4 krA[2], vrA[2], krB[2], vrB[2];
#pragma unroll
    for (int i = 0; i < 2; ++i) { krA[i] = pre.kr[i]; vrA[i] = pre.vr[i]; }
    if (PFD == 2) {
#pragma unroll
        for (int i = 0; i < 2; ++i) { krB[i] = *(const u32x4*)(kg[i] + (size_t)64 * D); vrB[i] = *(const u32x4*)(vg[i] + 64); } }
#pragma unroll
    for (int i = 0; i < 2; ++i) { *(LAS u32x4*)(lds + kl[i]) = krA[i]; *(LAS u32x4*)(lds + vl[i]) = vrA[i]; }
    __syncthreads();
    f32x16 o[4];
#pragma unroll
    for (int d0 = 0; d0 < 4; ++d0)
#pragma unroll
        for (int r = 0; r < 16; ++r) o[d0][r] = 0.f;
    float mref = 0.f, l = 0.f;
    const int kofs = (swap23(r32) * KROW + hi * 8) * 2, vofs = (r32 * KROW + hi * 8) * 2;
    const float posref = (float)(qb * 128 + 127);
    u32x4 pw[4]; bool pend = false;
#define LDV(dst, ks) do { _Pragma("unroll") for (int d0 = 0; d0 < 4; ++d0) dst[d0] = *(const LAS bf16x8*)(vb + d0 * 32 * KROW * 2 + (ks) * 32); } while (0)
#define PVM(ks, src) do { _Pragma("unroll") for (int d0 = 0; d0 < 4; ++d0) o[d0] = __builtin_amdgcn_mfma_f32_32x32x16_bf16(__builtin_bit_cast(bf16x8, pw[ks]), src[d0], o[d0], 0, 0, 0); } while (0)
#define PV_ALL(vstage) do { const LAS unsigned char* vb = (vstage) + 2 * K_BYTES + vofs; bf16x8 va[4], vn[4]; \
        LDV(va, 0); LDV(vn, 1); __builtin_amdgcn_sched_barrier(0); PVM(0, va); __builtin_amdgcn_sched_barrier(0); \
        LDV(va, 2); __builtin_amdgcn_sched_barrier(0); PVM(1, vn); __builtin_amdgcn_sched_barrier(0); \
        LDV(vn, 3); __builtin_amdgcn_sched_barrier(0); PVM(2, va); __builtin_amdgcn_sched_barrier(0); PVM(3, vn); __builtin_amdgcn_sched_barrier(0); } while (0)
    int sc = 0, sp = 0;
    auto tile_step = [&](const int t, u32x4 (&KL)[2], u32x4 (&VL)[2], u32x4 (&KW)[2], u32x4 (&VW)[2]) __attribute__((always_inline))     {
        LAS unsigned char* stg = lds + sc;
        if (t + PFD < NT) {
#pragma unroll
            for (int i = 0; i < 2; ++i) { KL[i] = *(const u32x4*)(kg[i] + (size_t)(t + PFD) * 64 * D); VL[i] = *(const u32x4*)(vg[i] + (t + PFD) * 64); }
        }
        const int kvb = 64 * t;
        if (kvb <= q0w + 31) {
            const LAS unsigned char* kb = stg + c * K_BYTES + kofs;
            bf16x8 ka[8];
#pragma unroll
            for (int d0 = 0; d0 < 4; ++d0) { ka[2 * d0] = *(const LAS bf16x8*)(kb + d0 * 32); ka[2 * d0 + 1] = *(const LAS bf16x8*)(kb + 32 * KROW * 2 + d0 * 32); }
            __builtin_amdgcn_sched_barrier(0);
            const float tcl = slope2 * ((float)(kvb + 8 * hi) - posref) - mref;
            f32x16 p0, p1;
#pragma unroll
            for (int r = 0; r < 16; ++r) { const float kvrel = (float)((r & 7) + 16 * (r >> 3)); p0[r] = __builtin_fmaf(slope2, kvrel, tcl); p1[r] = __builtin_fmaf(slope2, kvrel + 32.f, tcl); }
#pragma unroll
            for (int d0 = 0; d0 < 4; ++d0) {
                p0 = __builtin_amdgcn_mfma_f32_32x32x16_bf16(ka[2 * d0], qf[d0], p0, 0, 0, 0);
                p1 = __builtin_amdgcn_mfma_f32_32x32x16_bf16(ka[2 * d0 + 1], qf[d0], p1, 0, 0, 0); }
            asm volatile("s_nop 15\n\ts_nop 7" : "+v"(p0), "+v"(p1));
            __builtin_amdgcn_sched_barrier(0);
            if (kvb + 63 > q0w) {
                const int qabs = q0w + r32;
#pragma unroll
                for (int r = 0; r < 16; ++r) { const int kv = kvb + 8 * hi + (r & 7) + 16 * (r >> 3);
                    if (kv > qabs) p0[r] = -INFINITY; if (kv + 32 > qabs) p1[r] = -INFINITY; }
            }
            float mx = max3f(p0[0], p1[0], p0[1]), mx2 = max3f(p1[1], p0[2], p1[2]);
#pragma unroll
            for (int r = 3; r < 15; r += 2) { mx = max3f(mx, p0[r], p1[r]); mx2 = max3f(mx2, p0[r + 1], p1[r + 1]); }
            mx = max3f(mx, p0[15], p1[15]); mx = fmaxf(mx, mx2);
            mx = fmaxf(mx, __shfl_xor(mx, 32));
            if (t == 0 || __any(mx > 96.0f)) {
                const float dl = (t == 0) ? mx : fmaxf(mx, 0.f);
                mref += dl;
#pragma unroll
                for (int r = 0; r < 16; ++r) { p0[r] -= dl; p1[r] -= dl; }
                if (t != 0) {
                    const float alpha = __builtin_amdgcn_exp2f(-dl);
                    l *= alpha;
                    if (hi == 0) scr[r32] = alpha;
                    asm volatile("s_waitcnt lgkmcnt(0)" ::: "memory");
#pragma unroll
                    for (int r = 0; r < 16; ++r) { const float a = scr[crow(r, hi)];
#pragma unroll
                        for (int d0 = 0; d0 < 4; ++d0) o[d0][r] *= a; }
                }
            }
            const LAS unsigned char* vb = stg + 2 * K_BYTES + vofs;
            bf16x8 va[4], vn[4];
            LDV(va, 0); LDV(vn, 1);
            float sacc = 0.f;
#define EXPQ(k, q) do { float ea_, eb_; if ((k) < 2) { ea_ = __builtin_amdgcn_exp2f(p0[((k) & 1) * 8 + 2 * (q)]); eb_ = __builtin_amdgcn_exp2f(p0[((k) & 1) * 8 + 2 * (q) + 1]); } \
                                        else { ea_ = __builtin_amdgcn_exp2f(p1[((k) & 1) * 8 + 2 * (q)]); eb_ = __builtin_amdgcn_exp2f(p1[((k) & 1) * 8 + 2 * (q) + 1]); } \
                                        sacc += ea_; sacc += eb_; asm volatile("" : "+v"(sacc)); pw[k][q] = cvtpk(ea_, eb_); } while (0)
#define MMAQ(ks, src, d0) o[d0] = __builtin_amdgcn_mfma_f32_32x32x16_bf16(__builtin_bit_cast(bf16x8, pw[ks]), src[d0], o[d0], 0, 0, 0)
#define SB() __builtin_amdgcn_sched_barrier(0)
            EXPQ(0, 0); EXPQ(0, 1); EXPQ(0, 2); EXPQ(0, 3); SB();
            MMAQ(0, va, 0); EXPQ(1, 0); SB(); MMAQ(0, va, 1); EXPQ(1, 1); SB(); MMAQ(0, va, 2); EXPQ(1, 2); SB(); MMAQ(0, va, 3); EXPQ(1, 3); SB();
            LDV(va, 2); SB();
            MMAQ(1, vn, 0); EXPQ(2, 0); SB(); MMAQ(1, vn, 1); EXPQ(2, 1); SB(); MMAQ(1, vn, 2); EXPQ(2, 2); SB(); MMAQ(1, vn, 3); EXPQ(2, 3); SB();
            LDV(vn, 3); SB();
            MMAQ(2, va, 0); EXPQ(3, 0); SB(); MMAQ(2, va, 1); EXPQ(3, 1); SB(); MMAQ(2, va, 2); EXPQ(3, 2); SB(); MMAQ(2, va, 3); EXPQ(3, 3); SB();
            MMAQ(3, vn, 0); MMAQ(3, vn, 1); MMAQ(3, vn, 2); MMAQ(3, vn, 3); SB();
            l += sacc;
#undef EXPQ
#undef MMAQ
#undef SB
        }
        const int sn = (sc == (NSTG - 1) * STAGE) ? 0 : sc + STAGE;
        if (t + 1 < NT) {
            LAS unsigned char* nst = lds + sn;
#pragma unroll
            for (int i = 0; i < 2; ++i) { *(LAS u32x4*)(nst + kl[i]) = KW[i]; *(LAS u32x4*)(nst + vl[i]) = VW[i]; }
        }
        sp = sc; sc = sn;
        __syncthreads();
    };
    if (PFD == 2) { for (int t = 0; t < NT; t += 2) { tile_step(t, krA, vrA, krB, vrB); tile_step(t + 1, krB, vrB, krA, vrA); } }
    else { for (int t = 0; t < NT; ++t) tile_step(t, krA, vrA, krA, vrA); }
    __syncthreads();
    if (hn) attn_prefetch(nxt, nb, nh, nqb, Q, Kb, Vt);
    else {
#pragma unroll
        for (int d0 = 0; d0 < 4; ++d0) nxt.qf[d0] = (bf16x8){0, 0, 0, 0, 0, 0, 0, 0};
#pragma unroll
        for (int i = 0; i < 2; ++i) { nxt.kr[i] = (u32x4){0u, 0u, 0u, 0u}; nxt.vr[i] = (u32x4){0u, 0u, 0u, 0u}; } }
#undef LDV
#undef PVM
#undef PV_ALL
    l += __shfl_xor(l, 32);
    if (hi == 0) scr[r32] = l;
    asm volatile("s_waitcnt lgkmcnt(0)" ::: "memory");
    const float fmap = (c == 1) ? lam : 1.0f;
#pragma unroll
    for (int r = 0; r < 16; ++r) { const float il = fmap / scr[crow(r, hi)];
#pragma unroll
        for (int d0 = 0; d0 < 4; ++d0) o[d0][r] *= il; }
    LAS float* exch = (LAS float*)lds + qs * 4096;
    if (c == 1) {
#pragma unroll
        for (int d0 = 0; d0 < 4; ++d0)
#pragma unroll
            for (int r = 0; r < 16; ++r) exch[(d0 * 16 + r) * 64 + lane] = o[d0][r];
    }
    __syncthreads();
    if (c == 0) {
#pragma unroll
        for (int d0 = 0; d0 < 4; ++d0)
#pragma unroll
            for (int r = 0; r < 16; ++r) o[d0][r] -= exch[(d0 * 16 + r) * 64 + lane];
        LAS bf16_t* ost = (LAS bf16_t*)(lds + OFF_OST) + qs * 32 * OST_ROW;
#pragma unroll
        for (int r = 0; r < 16; ++r) {
            float ss = 0.f;
#pragma unroll
            for (int d0 = 0; d0 < 4; ++d0) ss += o[d0][r] * o[d0][r];
            ss += __shfl_xor(ss, 1); ss += __shfl_xor(ss, 2); ss += __shfl_xor(ss, 4); ss += __shfl_xor(ss, 8); ss += __shfl_xor(ss, 16);
            const float rs = 1.0f / sqrtf(ss * (1.0f / 128.0f) + EPS);
#pragma unroll
            for (int d0 = 0; d0 < 4; ++d0) ost[crow(r, hi) * OST_ROW + d0 * 32 + r32] = (bf16_t)f2bf(o[d0][r] * rs);
        }
        asm volatile("s_waitcnt lgkmcnt(0)" ::: "memory");
        bf16_t* og = O + (tok0 + q0w) * D + h * 128;
#pragma unroll
        for (int i = 0; i < 8; ++i) { const int id = i * 64 + lane, row = id >> 4, ch = id & 15;
            const u32x4 v = *(const LAS u32x4*)(ost + row * OST_ROW + ch * 8);
            *(u32x4*)(og + (size_t)row * D + ch * 8) = v; }
    }
    __syncthreads();
}
}

#define XB_TMO      128
#define XB_XCNT(j)  (256  + 64 * (j))
#define XB_XSUB(j)  (1280 + 64 * (j))
#define XB_XGEN(j)  (2304 + 64 * (j))
#define XB_TOP      3328
#define XB_TOPGEN   3392
#define XCD_BAR_WORDS 3456
#define XB_SPIN_CAP (1u << 18)

__device__ __forceinline__ unsigned xb_ld(unsigned* p)              { return __hip_atomic_load(p, __ATOMIC_RELAXED, __HIP_MEMORY_SCOPE_AGENT); }
__device__ __forceinline__ unsigned xb_add(unsigned* p, unsigned v) { return __hip_atomic_fetch_add(p, v, __ATOMIC_RELAXED, __HIP_MEMORY_SCOPE_AGENT); }
__device__ __forceinline__ unsigned xb_xcc_id() { return (unsigned)__builtin_amdgcn_s_getreg((3 << 11) | 20) & 0xFu; }
#define XB_SPIN(cond, bar) do { unsigned _sp = 0; while (cond) { __builtin_amdgcn_s_sleep(1); \
    if ((++_sp & 255u) == 0u) { if (xb_ld(&(bar)[XB_TMO])) break; if (_sp > XB_SPIN_CAP) { atomicAdd(&(bar)[XB_TMO], 1u); break; } } } } while (0)

struct XcdBarrier {
    unsigned* bar; unsigned x;
    volatile LAS unsigned* st;
};

__device__ __forceinline__ XcdBarrier xcd_barrier_post(unsigned* bar, volatile LAS unsigned* st) {
    XcdBarrier b; b.bar = bar; b.x = xb_xcc_id(); b.st = st;
    if (threadIdx.x == 0) (void)xb_add(&bar[XB_XCNT(b.x)], 1u);
    return b;
}
__device__ __forceinline__ void xcd_barrier_complete(unsigned* bar, unsigned x, unsigned& nloc, unsigned& nx) {
    const unsigned G = gridDim.x * gridDim.y * gridDim.z;
    unsigned sum, cnt, mine, sp = 0u;
    for (;;) {
        sum = 0u; cnt = 0u; mine = 0u;
#pragma unroll
        for (unsigned j = 0; j < 16; ++j) { const unsigned c = xb_ld(&bar[XB_XCNT(j)]); sum += c; cnt += (c > 0u) ? 1u : 0u; mine = (j == x) ? c : mine; }
        if (sum == G) break;
        __builtin_amdgcn_s_sleep(1);
        if ((++sp & 255u) == 0u) { if (xb_ld(&bar[XB_TMO])) break; if (sp > XB_SPIN_CAP) { atomicAdd(&bar[XB_TMO], 1u); break; } }
    }
    nloc = mine > 0u ? mine : 1u; nx = cnt > 0u ? cnt : 1u;
}

__device__ __forceinline__ void xcd_barrier(const XcdBarrier& b) {
    asm volatile("s_waitcnt vmcnt(0)" ::: "memory");
    __syncthreads();
    if (threadIdx.x == 0) {
        unsigned* bar = b.bar;
        __builtin_amdgcn_s_waitcnt(0);
        unsigned nloc = b.st[0], nx = b.st[1];
        if (nloc == 0u) { xcd_barrier_complete(bar, b.x, nloc, nx); b.st[0] = nloc; b.st[1] = nx; }
        const unsigned old = xb_add(&bar[XB_XSUB(b.x)], 1u);
        const unsigned gen = old / nloc;
        if (old + 1u == (gen + 1u) * nloc) {
            __builtin_amdgcn_fence(__ATOMIC_RELEASE, "agent");
            asm volatile("s_waitcnt vmcnt(0)" ::: "memory");
            const unsigned og = xb_add(&bar[XB_TOP], 1u);
            const unsigned tg = og / nx;
            if (og + 1u == (tg + 1u) * nx) xb_add(&bar[XB_TOPGEN], 1u);
            else XB_SPIN(xb_ld(&bar[XB_TOPGEN]) == tg, bar);
            __builtin_amdgcn_fence(__ATOMIC_ACQUIRE, "agent");
            xb_add(&bar[XB_XGEN(b.x)], 1u);
            asm volatile("s_waitcnt vmcnt(0)" ::: "memory");
        } else {
            XB_SPIN(xb_ld(&bar[XB_XGEN(b.x)]) == gen, bar);
            __builtin_amdgcn_fence(__ATOMIC_ACQUIRE, "agent");
            asm volatile("s_waitcnt vmcnt(0)" ::: "memory");
        }
    }
    __syncthreads();
}

#define XL_SUB(j)  (4096 + 64 * (j))
#define XL_GEN(j)  (4096 + 1024 + 64 * (j))
#define XL_RANK(j) (4096 + 2048 + 64 * (j))
__device__ __forceinline__ void xcd_local_barrier(unsigned* ctl, unsigned x) {
    asm volatile("s_waitcnt vmcnt(0)" ::: "memory");
    __syncthreads();
    if (threadIdx.x == 0) {
        const unsigned old = xb_add(&ctl[XL_SUB(x)], 1u), gen = old / 32u;
        if (old + 1u == (gen + 1u) * 32u) xb_add(&ctl[XL_GEN(x)], 1u);
        else XB_SPIN(xb_ld(&ctl[XL_GEN(x)]) == gen, ctl);
        __builtin_amdgcn_fence(__ATOMIC_ACQUIRE, "agent");
        asm volatile("s_waitcnt vmcnt(0)" ::: "memory");
    }
    __syncthreads();
}

enum { PH_GEMM = 0, PH_ROW = 1, PH_CONV = 2, PH_ATTN = 3, PH_PRO = 4 };
struct Phase {
    int type, sync;
    const bf16_t* A; const bf16_t* Bt; int Mg, Ng, Kg, mode, ldc; bf16_t* O; bf16_t* O2;
    const float* base; const float* g; float coef; float* outH; bf16_t* XN; int useF;
};
constexpr int NPHASE = 23;
__device__ __forceinline__ Phase get_phase(const Params& p, int ph) {
    unsigned char* ws = p.ws;
    bf16_t* XN = (bf16_t*)(ws + WS_XN); bf16_t* Fb = (bf16_t*)(ws + WS_F); bf16_t* HB = (bf16_t*)(ws + WS_HB);
    bf16_t* Ub = HB; bf16_t* Bg = HB + (size_t)M * D; bf16_t* Qb = HB; bf16_t* Ob = HB + (size_t)M * D;
    bf16_t* Kb = (bf16_t*)(ws + WS_K); bf16_t* Vt = (bf16_t*)(ws + WS_VT);
    const bf16_t* Wgu = (const bf16_t*)(ws + WS_WGU); const bf16_t* Wdn = (const bf16_t*)(ws + WS_WDN);
    const float* ng = p.in[3];
    Phase q; q.type = PH_GEMM; q.sync = 2; q.A = XN; q.Bt = Wgu; q.Mg = M; q.Ng = 2 * FF; q.Kg = D; q.mode = 1; q.ldc = FF; q.O = HB; q.O2 = nullptr;
    q.base = nullptr; q.g = ng; q.coef = 0.5f; q.outH = nullptr; q.XN = XN; q.useF = 1;
#define GU(j)  do { q.Bt = Wgu + (size_t)(j) * 2 * FF * D; } while (0)
#define DN(j)  do { q.A = HB; q.Bt = Wdn + (size_t)(j) * D * FF; q.Ng = D; q.Kg = FF; q.mode = 3; q.ldc = D; q.O = Fb; } while (0)
#define ROW(gi, cf) do { q.type = PH_ROW; q.g = ng + (gi) * D; q.coef = (cf); } while (0)
    switch (ph) {
    case 0: q.type = PH_PRO; q.sync = 1; break;
    case 1: GU(0); break;
    case 2: DN(0); break;
    case 3: ROW(1, 0.5f); q.base = p.in[0]; break;
    case 4: q.Bt = (const bf16_t*)(ws + WS_WCIN); q.Ng = 3 * D; q.mode = 2; q.ldc = D; q.O = Ub; q.O2 = Bg; q.sync = 1; break;
    case 5: q.type = PH_CONV; break;
    case 6: q.A = Kb; q.Bt = (const bf16_t*)(ws + WS_WCOUT); q.Ng = D; q.mode = 3; q.ldc = D; q.O = Fb; break;
    case 7: ROW(3, 1.0f); break;
    case 8: GU(1); break;
    case 9: DN(1); break;
    case 10: ROW(5, 0.5f); q.sync = 1; break;
    case 11: q.Bt = (const bf16_t*)(ws + WS_WK); q.Ng = D; q.mode = 0; q.ldc = D; q.O = Kb; q.sync = 0; break;
    case 12: q.A = (const bf16_t*)(ws + WS_WV); q.Bt = XN; q.Mg = D; q.Ng = M; q.mode = 0; q.ldc = M; q.O = Vt; q.sync = 0; break;
    case 13: GU(2); break;
    case 14: DN(2); break;
    case 15: ROW(6 + 1, 0.5f); break;
    case 16: q.Bt = (const bf16_t*)(ws + WS_WQ); q.Ng = D; q.mode = 0; q.ldc = D; q.O = Qb; q.sync = 1; break;
    case 17: q.type = PH_ATTN; q.sync = 1; break;
    case 18: q.A = Ob; q.Bt = (const bf16_t*)(ws + WS_WO); q.Ng = D; q.mode = 3; q.ldc = D; q.O = Fb; break;
    case 19: ROW(6 + 3, 1.0f); break;
    case 20: GU(3); break;
    case 21: DN(3); break;
    case 22: ROW(6 + 5, 0.5f); q.XN = nullptr; q.outH = p.out; q.sync = 0; break;
    default: q.type = -1; q.sync = 0; break;
    }
#undef GU
#undef DN
#undef ROW
    return q;
}

__global__ void __launch_bounds__(NTHREADS, 2) mega_fwd(Params p) {
    extern __shared__ __attribute__((aligned(16))) unsigned char lds_raw[];
    cg::grid_group grid = cg::this_grid();
    LAS unsigned char* lds = (LAS unsigned char*)lds_raw;
    const int G = gridDim.x, bx = blockIdx.x;
    int vcu = (G % 8 == 0) ? (bx % 8) * (G / 8) + bx / 8 : bx;
    const int NGW = G * NWAVES;
    unsigned char* ws = p.ws;
    volatile LAS unsigned* bst = (volatile LAS unsigned*)(lds + 131072 + 64);
    if (threadIdx.x < 8) bst[threadIdx.x] = 0u;
    __syncthreads();
    XcdBarrier bar = xcd_barrier_post((unsigned*)(ws + WS_CTL), bst);
    int cid = bx; bool localok = false; unsigned myx = 0u;
    {
        unsigned* ctl = (unsigned*)(ws + WS_CTL);
        if (threadIdx.x == 0) {
            const unsigned x = xb_xcc_id();
            const unsigned rank = xb_add(&ctl[XL_RANK(x)], 1u);
            unsigned sp_ = 0u, ok = 0u;
            for (;;) {
                unsigned sum = 0u, good = 0u;
#pragma unroll
                for (unsigned j = 0; j < 16; ++j) { const unsigned c_ = xb_ld(&ctl[XL_RANK(j)]); sum += c_; good += (j < 8u ? (c_ == 32u) : (c_ == 0u)) ? 1u : 0u; }
                if (sum == (unsigned)G) { ok = (good == 16u && G == 256) ? 1u : 0u; break; }
                __builtin_amdgcn_s_sleep(1);
                if (++sp_ > XB_SPIN_CAP) { ok = 0u; break; }
            }
            bst[2] = x; bst[3] = rank; bst[4] = ok;
        }
        __syncthreads();
        myx = bst[2]; const unsigned rank = bst[3]; localok = bst[4] != 0u;
        if (localok) { cid = (int)(myx + 8u * rank); vcu = (int)(myx * 32u + rank); }
    }
    if (p.out == nullptr) grid.sync();
    for (int ph = 0; ph < NPHASE; ++ph) {
        int tid_ = threadIdx.x; asm volatile("" : "+v"(tid_));
        const int tid = tid_, lane = tid & 63, wave = __builtin_amdgcn_readfirstlane(tid >> 6);
        const int gw = vcu * NWAVES + wave;
        const Phase q = get_phase(p, ph);
        if (q.type == PH_GEMM) {
            pg8::Gemm g{q.A, q.Bt, q.Mg, q.Ng, q.Kg}; pg8::StaticOrder S; S.init(q.Mg, q.Ng, G, cid);
            pg8::Epi E{q.mode, q.O, q.ldc, q.O2, (float*)(ws + WS_PART)};
            pg8::gemm_phase<pg8::Epi, pg8::StaticOrder, true, true>(lds, g, S, E);
            if ((ph == 1 || ph == 8 || ph == 13) && G == 256 && cid >= 128)
                convert_weights(p, lds, ph == 1 ? 3 : ph == 8 ? 1 : 2, (cid - 128) * NWAVES + wave, 128 * NWAVES, wave, lane);
        } else if (q.type == PH_ROW) {
            const int gwl = (vcu & 31) * NWAVES + wave, xr0 = (vcu >> 5) * 2048;
            rowpass(q.base, (const bf16_t*)(ws + WS_XN), (float*)(ws + WS_RINV), (const bf16_t*)(ws + WS_F), (const float*)(ws + WS_PART), q.g, q.coef, q.outH, q.XN,
                    localok ? xr0 + gwl : gw, localok ? xr0 + 2048 : M, localok ? 256 : NGW, lane);
        } else if (q.type == PH_CONV) {
            const bf16_t* HB = (const bf16_t*)(ws + WS_HB);
            const int gwl = (vcu & 31) * NWAVES + wave, xi0 = (vcu >> 5) * 512;
            convpass(HB, HB + (size_t)M * D, p.in[5], (bf16_t*)(ws + WS_K), localok ? xi0 + gwl : gw, localok ? xi0 + 512 : (M / 8) * 2, localok ? 256 : NGW, lane);
        } else if (q.type == PH_ATTN) {
            const float* lp = p.in[10];
            const float d1 = wave_sum(lp[lane] * lp[64 + lane]), d2 = wave_sum(lp[128 + lane] * lp[192 + lane]);
            const float lam = __expf(d1) - __expf(d2) + LAMBDA_INIT;
            bf16_t* HB = (bf16_t*)(ws + WS_HB);
            for (int v = vcu; v < 256; v += G) {
                const int xcd = v >> 5, j = v & 31;
                att::AttnPre cur, nxt;
                att::attn_prefetch(cur, (xcd * 4) >> 3, (xcd * 4) & 7, j, HB, (const bf16_t*)(ws + WS_K), (const bf16_t*)(ws + WS_VT));
                for (int i = 0; i < 4; ++i) {
                    const int bh = xcd * 4 + i, b = bh >> 3, h = bh & 7;
                    const float slope2 = exp2f(-(float)(h + 1)) * LOG2E;
                    const int qb = (i & 1) ? 31 - j : j;
                    const int bh1 = xcd * 4 + i + 1, qb1 = ((i + 1) & 1) ? 31 - j : j;
                    att::attn_unit(b, h, qb, HB, (const bf16_t*)(ws + WS_K), (const bf16_t*)(ws + WS_VT), HB + (size_t)M * D, lds, lam, slope2, cur, i < 3, bh1 >> 3, bh1 & 7, qb1, nxt);
                    cur = nxt;
                }
            }
        } else if (q.type == PH_PRO) {
            convert_weights(p, lds, 0, gw, NGW, wave, lane);
            if (G != 256) { convert_weights(p, lds, 3, gw, NGW, wave, lane); convert_weights(p, lds, 1, gw, NGW, wave, lane); convert_weights(p, lds, 2, gw, NGW, wave, lane); }
            rowpass(p.in[0], nullptr, (float*)(ws + WS_RINV), nullptr, nullptr, nullptr, 0.f, nullptr, (bf16_t*)(ws + WS_XN), gw, M, NGW, lane);
        }
        if (q.sync == 1 || (q.sync == 2 && !localok)) xcd_barrier(bar); else if (q.sync == 2) xcd_local_barrier((unsigned*)(ws + WS_CTL), myx);
    }
}

extern "C" void kernel_launch(void* const* d_in, const int* in_sizes, int n_in, void* d_out, int out_size, void* d_ws, size_t ws_size, hipStream_t stream) {
    static int grid = 0;
    if (grid == 0) {
        if (n_in != 13 || in_sizes[0] != M * D || out_size != M * D || ws_size < WS_END) {
            fprintf(stderr, "kernel_launch: unexpected shapes (n_in %d, in0 %d, out %d, ws %zu); nothing launched\n", n_in, n_in > 0 ? in_sizes[0] : -1, out_size, ws_size); grid = -1; return; }
        int dev = 0, cus = 0, per_cu = 0;
        (void)hipGetDevice(&dev);
        (void)hipDeviceGetAttribute(&cus, hipDeviceAttributeMultiprocessorCount, dev);
        if (hipFuncSetAttribute((const void*)mega_fwd, hipFuncAttributeMaxDynamicSharedMemorySize, LDS_BYTES) != hipSuccess) { fprintf(stderr, "kernel_launch: hipFuncSetAttribute failed\n"); grid = -1; return; }
        if (hipOccupancyMaxActiveBlocksPerMultiprocessor(&per_cu, (const void*)mega_fwd, NTHREADS, LDS_BYTES) != hipSuccess || per_cu < 1) per_cu = 1;
        (void)hipGetLastError();
        grid = cus * per_cu;
        if (grid > 256) grid = 256;
    }
    if (grid < 0) return;
    if (hipMemsetAsync((char*)d_ws + WS_CTL, 0, CTL_BYTES, stream) != hipSuccess) { fprintf(stderr, "kernel_launch: hipMemsetAsync failed\n"); return; }
    Params p{};
    for (int i = 0; i < 13; ++i) p.in[i] = (const float*)d_in[i];
    p.out = (float*)d_out; p.ws = (unsigned char*)d_ws;
    void* args[] = {&p};
    hipError_t e = hipLaunchCooperativeKernel((const void*)mega_fwd, dim3(grid), dim3(NTHREADS), args, LDS_BYTES, stream);
    if (e != hipSuccess) fprintf(stderr, "cooperative launch failed: %s (grid %d)\n", hipGetErrorString(e), grid);
}
```
